# Optimizing an MI355X kernel written in HIP

```python
import jax
import jax.numpy as jnp
from jax import lax

D_MODEL = 1024
BATCH = 4
SEQ = 8192
DEPTH = 2

HEAD_DIM = 64
Q_BLOCK = 128
ROPE_THETA = 10000.0
NORM_EPS = 1e-6

A_HEADS = 8
A_KV_HEADS = 2
IDX_HEADS = 4
IDX_DIM = 64
DSA_TOPK = 256
B_HEADS = 8
B_KV_HEADS = 2
SWA_WINDOW = 128
C_HEADS = 8
C_KV_HEADS = 2
CMP_STRIDE = 16
CMP_LEN = 2 * CMP_STRIDE
CMP_HIDDEN = 128
SLC_BLOCK = 64
SLC_TOPN = 16
NSA_WINDOW = 512
D_HEADS = 8
Q_LORA = 256
KV_LORA = 128
NOPE_DIM = 64
ROPE_DIM = 32
V_DIM = 64

N_EVEN = (DEPTH + 1) // 2
N_ODD = DEPTH // 2

AB_SPLITS = (A_HEADS * HEAD_DIM, A_KV_HEADS * HEAD_DIM, A_KV_HEADS * HEAD_DIM, IDX_HEADS * IDX_DIM, IDX_DIM, IDX_HEADS, A_HEADS * HEAD_DIM, B_HEADS * HEAD_DIM, B_KV_HEADS * HEAD_DIM, B_KV_HEADS * HEAD_DIM, B_HEADS * HEAD_DIM)
AB_COLS = sum(AB_SPLITS)
AB_WIDTH = (A_HEADS + B_HEADS) * HEAD_DIM
CD_SPLITS = (C_HEADS * HEAD_DIM,) + (C_KV_HEADS * HEAD_DIM,) * 6 + (C_HEADS * 3, C_HEADS * HEAD_DIM, Q_LORA, KV_LORA, ROPE_DIM, D_HEADS * V_DIM)
CD_COLS = sum(CD_SPLITS)
CD_WIDTH = C_HEADS * HEAD_DIM + D_HEADS * V_DIM

kernel_name = 'hybrid_dsa_swa_nsa_mla_trunk'


def rms_norm(z, g):
    zf = z.astype(jnp.float32)
    y = zf * lax.rsqrt(jnp.mean(zf * zf, axis=-1, keepdims=True) + NORM_EPS)
    return (y * g.astype(jnp.float32)).astype(z.dtype)


def rope_tables(pos, dim):
    inv = jnp.power(jnp.float32(ROPE_THETA), -jnp.arange(0, dim, 2, dtype=jnp.float32) / dim)
    ang = pos.astype(jnp.float32)[:, None] * inv[None, :]
    return jnp.cos(ang), jnp.sin(ang)


def apply_rope(z, cos, sin):
    half = z.shape[-1] // 2
    z1 = z[..., :half].astype(jnp.float32)
    z2 = z[..., half:].astype(jnp.float32)
    c, s = cos[:, None, :], sin[:, None, :]
    return jnp.concatenate([z1 * c - z2 * s, z2 * c + z1 * s], axis=-1).astype(z.dtype)


def masked_softmax(s, mask):
    s = jnp.where(mask, s.astype(jnp.float32), -jnp.inf)
    m = jnp.max(s, axis=-1, keepdims=True)
    m = jnp.where(jnp.isfinite(m), m, 0.0)
    p = jnp.exp(s - m)
    return p / jnp.maximum(jnp.sum(p, axis=-1, keepdims=True), 1e-30)


def split_cols(y, sizes):
    offs, acc = [], 0
    for s in sizes[:-1]:
        acc += s
        offs.append(acc)
    return jnp.split(y, offs, axis=-1)


def dsa_attention(q, k, v, qi, ki, wi, k_sel):
    bsz, seq = q.shape[:2]
    grp = A_HEADS // A_KV_HEADS
    scale = HEAD_DIM ** -0.5
    idx_scale = (IDX_DIM * IDX_HEADS) ** -0.5
    key_pos = jnp.arange(seq)
    gather = jax.vmap(lambda zb, ib: zb[ib])

    def block(i):
        t0 = i * Q_BLOCK
        t = t0 + jnp.arange(Q_BLOCK)
        qb = lax.dynamic_slice_in_dim(q, t0, Q_BLOCK, 1).reshape(bsz, Q_BLOCK, A_KV_HEADS, grp, HEAD_DIM)
        qib = lax.dynamic_slice_in_dim(qi, t0, Q_BLOCK, 1)
        wib = lax.dynamic_slice_in_dim(wi, t0, Q_BLOCK, 1).astype(jnp.float32)
        logits = jnp.einsum('bqhd,bsd->bqhs', qib, ki).astype(jnp.float32)
        score = jnp.einsum('bqh,bqhs->bqs', wib, jax.nn.relu(logits)) * idx_scale
        causal = key_pos[None, :] <= t[:, None]
        score = jnp.where(causal[None], score, -jnp.inf)
        _, idx = lax.top_k(score, k_sel)
        valid = idx <= t[None, :, None]
        ks = gather(k, idx)
        vs = gather(v, idx)
        s = jnp.einsum('bqgrd,bqkgd->bqgrk', qb, ks) * scale
        p = masked_softmax(s, valid[:, :, None, None, :])
        o = jnp.einsum('bqgrk,bqkgd->bqgrd', p.astype(v.dtype), vs)
        return o.reshape(bsz, Q_BLOCK, A_HEADS * HEAD_DIM)

    out = lax.map(block, jnp.arange(seq // Q_BLOCK))
    return out.transpose(1, 0, 2, 3).reshape(bsz, seq, A_HEADS * HEAD_DIM)


def swa_sink_attention(q, k, v, sinks):
    bsz, seq = q.shape[:2]
    nb = seq // Q_BLOCK
    grp = B_HEADS // B_KV_HEADS
    scale = HEAD_DIM ** -0.5
    qb = q.reshape(bsz, nb, Q_BLOCK, B_KV_HEADS, grp, HEAD_DIM)

    def band(z):
        zp = jnp.pad(z, ((0, 0), (Q_BLOCK, 0), (0, 0), (0, 0))).reshape(bsz, nb + 1, Q_BLOCK, B_KV_HEADS, HEAD_DIM)
        return jnp.concatenate([zp[:, :-1], zp[:, 1:]], axis=2)

    kb, vb = band(k), band(v)
    s = jnp.einsum('bnqgrd,bnkgd->bngrqk', qb, kb).astype(jnp.float32) * scale
    qi = jnp.arange(Q_BLOCK)[None, :, None]
    kj = jnp.arange(2 * Q_BLOCK)[None, None, :]
    blk = jnp.arange(nb)[:, None, None]
    diff = qi + Q_BLOCK - kj
    key_abs = (blk - 1) * Q_BLOCK + kj
    mask = (diff >= 0) & (diff < SWA_WINDOW) & (key_abs >= 0)
    s = jnp.where(mask[None, :, None, None], s, -jnp.inf)
    sink = sinks.astype(jnp.float32).reshape(1, 1, B_KV_HEADS, grp, 1, 1)
    m = jnp.maximum(jnp.max(s, axis=-1, keepdims=True), sink)
    p = jnp.exp(s - m)
    p = p / (jnp.sum(p, axis=-1, keepdims=True) + jnp.exp(sink - m))
    o = jnp.einsum('bngrqk,bnkgd->bnqgrd', p.astype(v.dtype), vb)
    return o.reshape(bsz, seq, B_HEADS * HEAD_DIM)


def nsa_compress(z, pe, w1, w2):
    bsz, seq = z.shape[:2]
    ch = z.reshape(bsz, seq // CMP_STRIDE, CMP_STRIDE, C_KV_HEADS, HEAD_DIM)
    blocks = jnp.concatenate([ch[:, :-1], ch[:, 1:]], axis=2) + pe[None, None, :, None, :]
    flat = blocks.transpose(0, 1, 3, 2, 4).reshape(bsz, seq // CMP_STRIDE - 1, C_KV_HEADS, CMP_LEN * HEAD_DIM)
    return jax.nn.silu(flat @ w1) @ w2


def nsa_attention(q, kc, vc, ks, vs, kw, vw, gates, n_sel):
    bsz, seq = q.shape[:2]
    n_cmp = kc.shape[1]
    n_slc = seq // SLC_BLOCK
    grp = C_HEADS // C_KV_HEADS
    scale = HEAD_DIM ** -0.5
    ratio = SLC_BLOCK // CMP_STRIDE
    pad_back = ratio * n_slc + ratio - n_cmp - 1
    cmp_end = jnp.arange(n_cmp) * CMP_STRIDE + (CMP_LEN - 1)
    blk_ids = jnp.arange(n_slc)
    w_overlap = jnp.where(jnp.arange(ratio) == 0, 1.0, 2.0).astype(jnp.float32)
    ks_blk = ks.reshape(bsz, n_slc, SLC_BLOCK, C_KV_HEADS, HEAD_DIM).transpose(0, 3, 1, 2, 4)
    vs_blk = vs.reshape(bsz, n_slc, SLC_BLOCK, C_KV_HEADS, HEAD_DIM).transpose(0, 3, 1, 2, 4)
    kw_pad = jnp.pad(kw, ((0, 0), (NSA_WINDOW, 0), (0, 0), (0, 0)))
    vw_pad = jnp.pad(vw, ((0, 0), (NSA_WINDOW, 0), (0, 0), (0, 0)))
    gather = jax.vmap(jax.vmap(lambda zb, ib: zb[ib]))
    j_w = jnp.arange(Q_BLOCK + NSA_WINDOW)
    diff_w = jnp.arange(Q_BLOCK)[:, None] + NSA_WINDOW - j_w[None, :]

    def block(i):
        t0 = i * Q_BLOCK
        t = t0 + jnp.arange(Q_BLOCK)
        qb = lax.dynamic_slice_in_dim(q, t0, Q_BLOCK, 1).reshape(bsz, Q_BLOCK, C_KV_HEADS, grp, HEAD_DIM)
        gb = lax.dynamic_slice_in_dim(gates, t0, Q_BLOCK, 1).reshape(bsz, Q_BLOCK, C_KV_HEADS, grp, 3)
        s_c = jnp.einsum('bqgrd,bngd->bqgrn', qb, kc) * scale
        mask_c = cmp_end[None, :] <= t[:, None]
        p_c = masked_softmax(s_c, mask_c[None, :, None, None, :])
        o_c = jnp.einsum('bqgrn,bngd->bqgrd', p_c.astype(vc.dtype), vc)
        imp = jnp.pad(jnp.sum(p_c, axis=3), ((0, 0), (0, 0), (0, 0), (1, pad_back)))
        imp_s = jnp.sum(imp[..., :ratio * n_slc].reshape(bsz, Q_BLOCK, C_KV_HEADS, n_slc, ratio) * w_overlap, axis=-1) + imp[..., ratio::ratio]
        cur = t // SLC_BLOCK
        admiss = blk_ids[None, :] <= cur[:, None]
        forced = (blk_ids[None, :] == 0) | (blk_ids[None, :] >= cur[:, None] - 1)
        imp_s = jnp.where((admiss & forced)[None, :, None, :], jnp.inf, imp_s)
        imp_s = jnp.where(admiss[None, :, None, :], imp_s, -jnp.inf)
        _, sel = lax.top_k(imp_s, n_sel)
        sel_t = sel.transpose(0, 2, 1, 3)
        k_sel = gather(ks_blk, sel_t)
        v_sel = gather(vs_blk, sel_t).reshape(bsz, C_KV_HEADS, Q_BLOCK, n_sel * SLC_BLOCK, HEAD_DIM)
        s_s = jnp.einsum('bqgrd,bgqnld->bqgrnl', qb, k_sel) * scale
        s_s = s_s.reshape(bsz, Q_BLOCK, C_KV_HEADS, grp, n_sel * SLC_BLOCK)
        tok = sel[..., None] * SLC_BLOCK + jnp.arange(SLC_BLOCK)
        mask_s = (tok <= t[None, :, None, None, None]).reshape(bsz, Q_BLOCK, C_KV_HEADS, 1, n_sel * SLC_BLOCK)
        p_s = masked_softmax(s_s, mask_s)
        o_s = jnp.einsum('bqgrm,bgqmd->bqgrd', p_s.astype(vs.dtype), v_sel)
        kwb = lax.dynamic_slice_in_dim(kw_pad, t0, Q_BLOCK + NSA_WINDOW, 1)
        vwb = lax.dynamic_slice_in_dim(vw_pad, t0, Q_BLOCK + NSA_WINDOW, 1)
        s_w = jnp.einsum('bqgrd,bkgd->bqgrk', qb, kwb) * scale
        mask_w = (diff_w >= 0) & (diff_w < NSA_WINDOW) & ((t0 - NSA_WINDOW + j_w)[None, :] >= 0)
        p_w = masked_softmax(s_w, mask_w[None, :, None, None, :])
        o_w = jnp.einsum('bqgrk,bkgd->bqgrd', p_w.astype(vw.dtype), vwb)
        o = gb[..., 0:1] * o_c + gb[..., 1:2] * o_s + gb[..., 2:3] * o_w
        return o.reshape(bsz, Q_BLOCK, C_HEADS * HEAD_DIM)

    out = lax.map(block, jnp.arange(seq // Q_BLOCK))
    return out.transpose(1, 0, 2, 3).reshape(bsz, seq, C_HEADS * HEAD_DIM)


def mla_attention(q_nope, q_rope, k_nope, k_rope, v):
    bsz, seq = q_nope.shape[:2]
    scale = (NOPE_DIM + ROPE_DIM) ** -0.5
    key_pos = jnp.arange(seq)

    def block(i):
        t0 = i * Q_BLOCK
        t = t0 + jnp.arange(Q_BLOCK)
        qn = lax.dynamic_slice_in_dim(q_nope, t0, Q_BLOCK, 1)
        qr = lax.dynamic_slice_in_dim(q_rope, t0, Q_BLOCK, 1)
        s = (jnp.einsum('bqhd,bshd->bhqs', qn, k_nope) + jnp.einsum('bqhd,bsd->bhqs', qr, k_rope)) * scale
        mask = key_pos[None, :] <= t[:, None]
        p = masked_softmax(s, mask[None, None])
        o = jnp.einsum('bhqs,bshd->bqhd', p.astype(v.dtype), v)
        return o.reshape(bsz, Q_BLOCK, D_HEADS * V_DIM)

    out = lax.map(block, jnp.arange(seq // Q_BLOCK))
    return out.transpose(1, 0, 2, 3).reshape(bsz, seq, D_HEADS * V_DIM)


def layer_ab(x, norm_g, w_in, a_qk_norm, a_kidx_norm, b_qk_norm, b_sinks, w_out):
    bsz, seq, _ = x.shape
    y = rms_norm(x, norm_g) @ w_in
    qa, ka, va, qi, ki, wi, za, qb, kb, vb, zb = split_cols(y, AB_SPLITS)
    pos = jnp.arange(seq)
    cos, sin = rope_tables(pos, HEAD_DIM)
    icos, isin = rope_tables(pos, IDX_DIM)

    def heads(z, n):
        return z.reshape(bsz, seq, n, HEAD_DIM)

    qa = apply_rope(rms_norm(heads(qa, A_HEADS), a_qk_norm[0]), cos, sin)
    ka = apply_rope(rms_norm(heads(ka, A_KV_HEADS), a_qk_norm[1]), cos, sin)
    qi = apply_rope(qi.reshape(bsz, seq, IDX_HEADS, IDX_DIM), icos, isin)
    ki = apply_rope(rms_norm(ki, a_kidx_norm)[:, :, None, :], icos, isin)[:, :, 0]
    k_sel = min(DSA_TOPK, seq // 4)
    oa = dsa_attention(qa, ka, heads(va, A_KV_HEADS), qi, ki, wi, k_sel)
    qb = apply_rope(rms_norm(heads(qb, B_HEADS), b_qk_norm[0]), cos, sin)
    kb = apply_rope(rms_norm(heads(kb, B_KV_HEADS), b_qk_norm[1]), cos, sin)
    ob = swa_sink_attention(qb, kb, heads(vb, B_KV_HEADS), b_sinks)
    mix = jnp.concatenate([oa * jax.nn.silu(za), ob * jax.nn.silu(zb)], axis=-1)
    return x + mix @ w_out


def layer_cd(x, norm_g, w_in, c_q_norm, c_k_norm, c_cmp_pe, c_cmp_w1, c_cmp_w2, d_q_lat_norm, d_kv_lat_norm, d_w_uq, d_w_ukv, d_nope_norm, d_rope_norm, w_out):
    bsz, seq, _ = x.shape
    y = rms_norm(x, norm_g) @ w_in
    qc, kc, vc, ks, vs, kw, vw, gc, zc, cq, ckv, kr, zd = split_cols(y, CD_SPLITS)
    pos = jnp.arange(seq)
    cos, sin = rope_tables(pos, HEAD_DIM)

    def heads(z, n):
        return z.reshape(bsz, seq, n, HEAD_DIM)

    qc = apply_rope(rms_norm(heads(qc, C_HEADS), c_q_norm), cos, sin)
    kc = nsa_compress(heads(kc, C_KV_HEADS), c_cmp_pe[0], c_cmp_w1[0], c_cmp_w2[0])
    vc = nsa_compress(heads(vc, C_KV_HEADS), c_cmp_pe[1], c_cmp_w1[1], c_cmp_w2[1])
    n_cmp = kc.shape[1]
    ccos, csin = rope_tables(jnp.arange(n_cmp) * CMP_STRIDE + (CMP_LEN - 1), HEAD_DIM)
    kc = apply_rope(rms_norm(kc, c_k_norm[0]), ccos, csin)
    ks = apply_rope(rms_norm(heads(ks, C_KV_HEADS), c_k_norm[1]), cos, sin)
    kw = apply_rope(rms_norm(heads(kw, C_KV_HEADS), c_k_norm[2]), cos, sin)
    gates = jax.nn.sigmoid(gc.reshape(bsz, seq, C_HEADS, 3))
    n_sel = min(SLC_TOPN, seq // SLC_BLOCK)
    oc = nsa_attention(qc, kc, vc, ks, heads(vs, C_KV_HEADS), kw, heads(vw, C_KV_HEADS), gates, n_sel)
    q = (rms_norm(cq, d_q_lat_norm) @ d_w_uq).reshape(bsz, seq, D_HEADS, NOPE_DIM + ROPE_DIM)
    kv = (rms_norm(ckv, d_kv_lat_norm) @ d_w_ukv).reshape(bsz, seq, D_HEADS, NOPE_DIM + V_DIM)
    rcos, rsin = rope_tables(pos, ROPE_DIM)
    q_nope = rms_norm(q[..., :NOPE_DIM], d_nope_norm[0])
    q_rope = apply_rope(rms_norm(q[..., NOPE_DIM:], d_rope_norm[0]), rcos, rsin)
    k_nope = rms_norm(kv[..., :NOPE_DIM], d_nope_norm[1])
    k_rope = apply_rope(rms_norm(kr[:, :, None, :], d_rope_norm[1]), rcos, rsin)[:, :, 0]
    od = mla_attention(q_nope, q_rope, k_nope, k_rope, kv[..., NOPE_DIM:])
    mix = jnp.concatenate([oc * jax.nn.silu(zc), od * jax.nn.silu(zd)], axis=-1)
    return x + mix @ w_out


def setup_inputs(seed: int = 0) -> dict:
    key = jax.random.key(seed)
    k = jax.random.split(key, 22)
    f32 = jnp.float32

    def w(kk, shape, fan_in):
        return jax.random.normal(kk, shape, f32) * (fan_in ** -0.5)

    def gain(kk, shape):
        return 1.0 + 0.05 * jax.random.normal(kk, shape, f32)

    return {
        'x': jax.random.normal(k[0], (BATCH, SEQ, D_MODEL), f32),
        'ab_norm': gain(k[1], (N_EVEN, D_MODEL)),
        'ab_w_in': w(k[2], (N_EVEN, D_MODEL, AB_COLS), D_MODEL),
        'a_qk_norm': gain(k[3], (N_EVEN, 2, HEAD_DIM)),
        'a_kidx_norm': gain(k[4], (N_EVEN, IDX_DIM)),
        'b_qk_norm': gain(k[5], (N_EVEN, 2, HEAD_DIM)),
        'b_sinks': 0.5 * jax.random.normal(k[6], (N_EVEN, B_HEADS), f32),
        'ab_w_out': w(k[7], (N_EVEN, AB_WIDTH, D_MODEL), AB_WIDTH),
        'cd_norm': gain(k[8], (N_ODD, D_MODEL)),
        'cd_w_in': w(k[9], (N_ODD, D_MODEL, CD_COLS), D_MODEL),
        'c_q_norm': gain(k[10], (N_ODD, HEAD_DIM)),
        'c_k_norm': gain(k[11], (N_ODD, 3, HEAD_DIM)),
        'c_cmp_pe': 0.1 * jax.random.normal(k[12], (N_ODD, 2, CMP_LEN, HEAD_DIM), f32),
        'c_cmp_w1': w(k[13], (N_ODD, 2, CMP_LEN * HEAD_DIM, CMP_HIDDEN), CMP_LEN * HEAD_DIM),
        'c_cmp_w2': w(k[14], (N_ODD, 2, CMP_HIDDEN, HEAD_DIM), CMP_HIDDEN),
        'd_q_lat_norm': gain(k[15], (N_ODD, Q_LORA)),
        'd_kv_lat_norm': gain(k[16], (N_ODD, KV_LORA)),
        'd_w_uq': w(k[17], (N_ODD, Q_LORA, D_HEADS * (NOPE_DIM + ROPE_DIM)), Q_LORA),
        'd_w_ukv': w(k[18], (N_ODD, KV_LORA, D_HEADS * (NOPE_DIM + V_DIM)), KV_LORA),
        'd_nope_norm': gain(k[19], (N_ODD, 2, NOPE_DIM)),
        'd_rope_norm': gain(k[20], (N_ODD, 2, ROPE_DIM)),
        'cd_w_out': w(k[21], (N_ODD, CD_WIDTH, D_MODEL), CD_WIDTH),
    }


def reference(x, ab_norm, ab_w_in, a_qk_norm, a_kidx_norm, b_qk_norm, b_sinks, ab_w_out, cd_norm, cd_w_in, c_q_norm, c_k_norm, c_cmp_pe, c_cmp_w1, c_cmp_w2, d_q_lat_norm, d_kv_lat_norm, d_w_uq, d_w_ukv, d_nope_norm, d_rope_norm, cd_w_out):
    for layer in range(DEPTH):
        j = layer // 2
        if layer % 2 == 0:
            x = layer_ab(x, ab_norm[j], ab_w_in[j], a_qk_norm[j], a_kidx_norm[j], b_qk_norm[j], b_sinks[j], ab_w_out[j])
        else:
            x = layer_cd(x, cd_norm[j], cd_w_in[j], c_q_norm[j], c_k_norm[j], c_cmp_pe[j], c_cmp_w1[j], c_cmp_w2[j], d_q_lat_norm[j], d_kv_lat_norm[j], d_w_uq[j], d_w_ukv[j], d_nope_norm[j], d_rope_norm[j], cd_w_out[j])
    return x
```

```cpp
#include <hip/hip_runtime.h>
#include <hip/hip_cooperative_groups.h>
#include <cstdio>
#include <cstdint>
namespace cg = cooperative_groups;

typedef unsigned short u16;
typedef short bf16x8 __attribute__((ext_vector_type(8)));
typedef float f32x4 __attribute__((ext_vector_type(4)));
typedef float f32x2 __attribute__((ext_vector_type(2)));
typedef unsigned u32x4 __attribute__((ext_vector_type(4)));
typedef unsigned u32x2 __attribute__((ext_vector_type(2)));
typedef __bf16 bf16x2_t __attribute__((ext_vector_type(2)));
typedef short v4i16_t __attribute__((ext_vector_type(4)));
#define LAS __attribute__((address_space(3)))

constexpr int T = 32768, SEQ = 8192, DM = 1024, NB = 4;
constexpr int AB_N = 3072, CD_N = 2816;
constexpr float EPS = 1e-6f;
constexpr float LOG2E = 1.4426950408889634f;
constexpr float QS64 = 0.125f * LOG2E;
constexpr float QS96 = 0.10206207261596575f * LOG2E;

constexpr size_t MiB = 1048576;
constexpr size_t WS_W0T = 0;
constexpr size_t WS_WO0T = 6 * MiB;
constexpr size_t WS_W1T = 8 * MiB;
constexpr size_t WS_WO1T = 14 * MiB;
constexpr size_t WS_WUQT = 16 * MiB;
constexpr size_t WS_WUKVT = 16 * MiB + 512 * 1024;
constexpr size_t WS_WC1T = 17 * MiB;
constexpr size_t WS_WC2T = 18 * MiB;
constexpr size_t WS_CBIAS = 18 * MiB + 64 * 1024;
constexpr size_t WS_ROPE64 = 19 * MiB;
constexpr size_t WS_ROPE32 = 21 * MiB;
constexpr size_t WS_SSQ0 = 22 * MiB;
constexpr size_t WS_BAR = 22 * MiB + 768 * 1024;
constexpr size_t WS_SSQ1P = 23 * MiB;
constexpr size_t WS_XB = 26 * MiB;
constexpr size_t WS_MIX = 90 * MiB;
constexpr size_t WS_L = 154 * MiB;
constexpr size_t L0_QA = WS_L;
constexpr size_t L0_KVA = L0_QA + 32 * MiB;
constexpr size_t L0_QI = L0_KVA + 16 * MiB;
constexpr size_t L0_KI = L0_QI + 16 * MiB;
constexpr size_t L0_WI = L0_KI + 4 * MiB;
constexpr size_t L0_QB = L0_WI + 1 * MiB;
constexpr size_t L0_KVB = L0_QB + 32 * MiB;
constexpr size_t L0_IDX = L0_KVB + 16 * MiB;
constexpr size_t L0_CAND = L0_IDX + 16 * MiB;
constexpr size_t L0_END = L0_CAND + 128 * MiB;
constexpr size_t L1_QC = WS_L;
constexpr size_t L1_KCR = L1_QC + 32 * MiB;
constexpr size_t L1_VCR = L1_KCR + 8 * MiB;
constexpr size_t L1_KVS = L1_VCR + 8 * MiB;
constexpr size_t L1_KVW = L1_KVS + 16 * MiB;
constexpr size_t L1_GATES = L1_KVW + 16 * MiB;
constexpr size_t L1_CQ = L1_GATES + 3 * MiB;
constexpr size_t L1_CKV = L1_CQ + 16 * MiB;
constexpr size_t L1_SSQQ = L1_CKV + 8 * MiB;
constexpr size_t L1_SSQKV = L1_SSQQ + 1 * MiB;
constexpr size_t L1_KROPE = L1_SSQKV + 1 * MiB;
constexpr size_t L1_QM = L1_KROPE + 2 * MiB;
constexpr size_t L1_KN = L1_QM + 48 * MiB;
constexpr size_t L1_VM = L1_KN + 32 * MiB;
constexpr size_t L1_KCMP = L1_VM + 32 * MiB;
constexpr size_t L1_VCMP = L1_KCMP + 1 * MiB;
constexpr size_t L1_END = L1_VCMP + 1 * MiB;
constexpr size_t WS_NEED = (L1_END > L0_END ? L1_END : L0_END);

struct Params {
  const float* in[22];
  float* out;
  unsigned char* ws;
  int ph_lo, ph_hi;
};
enum { I_X = 0, I_AB_NORM, I_AB_WIN, I_A_QKN, I_A_KIDXN, I_B_QKN, I_B_SINKS, I_AB_WOUT, I_CD_NORM, I_CD_WIN, I_C_QN, I_C_KN, I_C_PE, I_C_W1, I_C_W2,
       I_D_QLN, I_D_KVLN, I_D_WUQ, I_D_WUKV, I_D_NOPEN, I_D_ROPEN, I_CD_WOUT };

__device__ __forceinline__ unsigned cvtpk(float lo, float hi) { f32x2 v = {lo, hi}; bf16x2_t b = __builtin_convertvector(v, bf16x2_t); return __builtin_bit_cast(unsigned, b); }
__device__ __forceinline__ float bflo(unsigned w) { return __uint_as_float(w << 16); }
__device__ __forceinline__ float bfhi(unsigned w) { return __uint_as_float(w & 0xffff0000u); }
__device__ __forceinline__ float bf1(u16 h) { return __uint_as_float((unsigned)h << 16); }
__device__ __forceinline__ float rsum4(float s) {
  auto a = __builtin_amdgcn_permlane16_swap(__float_as_uint(s), __float_as_uint(s), false, false); s = __uint_as_float(a[0]) + __uint_as_float(a[1]);
  auto b = __builtin_amdgcn_permlane32_swap(__float_as_uint(s), __float_as_uint(s), false, false); return __uint_as_float(b[0]) + __uint_as_float(b[1]); }
__device__ __forceinline__ float rmax4(float s) {
  auto a = __builtin_amdgcn_permlane16_swap(__float_as_uint(s), __float_as_uint(s), false, false); s = fmaxf(__uint_as_float(a[0]), __uint_as_float(a[1]));
  auto b = __builtin_amdgcn_permlane32_swap(__float_as_uint(s), __float_as_uint(s), false, false); return fmaxf(__uint_as_float(b[0]), __uint_as_float(b[1])); }
__device__ __forceinline__ float wave_sum(float v) {
#pragma unroll
  for (int o = 1; o < 64; o <<= 1) v += __shfl_xor(v, o);
  return v;
}
__device__ __forceinline__ float silu_f(float z) { return z * __builtin_amdgcn_rcpf(1.f + __builtin_amdgcn_exp2f(-z * LOG2E)); }
__device__ __forceinline__ float sigmoid_f(float z) { return __builtin_amdgcn_rcpf(1.f + __builtin_amdgcn_exp2f(-z * LOG2E)); }
#define MFMA16(a, b, c) __builtin_amdgcn_mfma_f32_16x16x32_bf16((a), (b), (c), 0, 0, 0)

struct MapId { __device__ static int f(int n) { return n; } };
struct MapAB { __device__ static int f(int n) { return n < 1092 ? n : ((n < 1152 || n >= 2944) ? -1 : n - 60); } };
struct MapCD { __device__ static int f(int n) {
  if (n < 1304) return n;
  if (n < 1344) return -1;
  if (n < 2272) return n - 40;
  if (n < 2304) return -1;
  return n - 72; } };
struct MapUQ { __device__ static int f(int n) { if (n < 512) return (n >> 6) * 96 + (n & 63); const int m = n - 512; return (m >> 5) * 96 + 64 + (m & 31); } };
struct MapUKV { __device__ static int f(int n) { if (n < 512) return (n >> 6) * 128 + (n & 63); const int m = n - 512; return (m >> 6) * 128 + 64 + (m & 63); } };

struct LayNone { __device__ static bool f(int) { return false; } };
struct LayCD { __device__ static bool f(int g) { return g == 35; } };
struct LayUQ { __device__ static bool f(int g) { return g >= 8; } };
template <class LA> __device__ __forceinline__ int perm256(int P) {
  const int wc = (P >> 5) & 3, bj = (P >> 7) & 1, n = (P >> 4) & 1, fq = (P >> 2) & 3, r = P & 3, g = (P >> 8) * 4 + wc;
  return (P & ~255) + 64 * wc + 32 * bj + (LA::f(g) ? 16 * n + 4 * fq : 8 * fq + 4 * n) + r;
}
template <class Map, bool PERM = false, class LA = LayNone>
__device__ __forceinline__ void conv_job(const float* __restrict__ W, int K, int ldsrc, u16* WT, int Ndst, const float* __restrict__ gain, float* scr, int lane, int& it0, int gw, int NGW) {
  const int nblk = Ndst / 32, nitems = (K / 64) * nblk;
  int first = gw - (it0 % NGW); if (first < 0) first += NGW;
  for (int it = first; it < nitems; it += NGW) {
    const int kb = it / nblk, nb = it % nblk, k0 = 64 * kb, n0 = 32 * nb;
    const int sc = Map::f(PERM ? perm256<LA>(n0 + (lane & 31)) : n0 + (lane & 31));
#pragma unroll 8
    for (int i = 0; i < 32; ++i) {
      const int kk = 2 * i + (lane >> 5);
      float v = 0.f;
      if (sc >= 0) { v = W[(size_t)(k0 + kk) * ldsrc + sc]; if (gain) v *= gain[k0 + kk]; }
      scr[kk * 33 + (lane & 31)] = v;
    }
    __builtin_amdgcn_wave_barrier();
    const int c = lane & 7;
#pragma unroll
    for (int j = 0; j < 4; ++j) {
      const int n = (lane >> 3) + 8 * j; const float* s = scr + (8 * c) * 33 + n;
      u32x4 o; o.x = cvtpk(s[0], s[33]); o.y = cvtpk(s[66], s[99]); o.z = cvtpk(s[132], s[165]); o.w = cvtpk(s[198], s[231]);
      *(u32x4*)(WT + (size_t)(n0 + n) * K + k0 + 8 * c) = o;
    }
    __builtin_amdgcn_wave_barrier();
  }
  it0 += nitems;
}

__device__ __forceinline__ void phase0(const Params& p, char* lds) {
  const int tid = threadIdx.x, lane = tid & 63, wid = tid >> 6;
  const int gw = blockIdx.x * 8 + wid, NGW = gridDim.x * 8;
  unsigned char* ws = p.ws;
  float* scr = (float*)(lds + wid * 8704);
  int it0 = 0;
  conv_job<MapAB, true>(p.in[I_AB_WIN], 1024, 2884, (u16*)(ws + WS_W0T), AB_N, p.in[I_AB_NORM], scr, lane, it0, gw, NGW);
  conv_job<MapId, true>(p.in[I_AB_WOUT], 1024, 1024, (u16*)(ws + WS_WO0T), 1024, nullptr, scr, lane, it0, gw, NGW);
  conv_job<MapCD, true, LayCD>(p.in[I_CD_WIN], 1024, 2744, (u16*)(ws + WS_W1T), CD_N, p.in[I_CD_NORM], scr, lane, it0, gw, NGW);
  conv_job<MapId, true>(p.in[I_CD_WOUT], 1024, 1024, (u16*)(ws + WS_WO1T), 1024, nullptr, scr, lane, it0, gw, NGW);
  conv_job<MapUQ, true, LayUQ>(p.in[I_D_WUQ], 256, 768, (u16*)(ws + WS_WUQT), 768, p.in[I_D_QLN], scr, lane, it0, gw, NGW);
  conv_job<MapUKV, true>(p.in[I_D_WUKV], 128, 1024, (u16*)(ws + WS_WUKVT), 1024, p.in[I_D_KVLN], scr, lane, it0, gw, NGW);
  conv_job<MapId>(p.in[I_C_W1], 2048, 128, (u16*)(ws + WS_WC1T), 128, nullptr, scr, lane, it0, gw, NGW);
  conv_job<MapId>(p.in[I_C_W1] + 2048 * 128, 2048, 128, (u16*)(ws + WS_WC1T) + 128 * 2048, 128, nullptr, scr, lane, it0, gw, NGW);
  conv_job<MapId>(p.in[I_C_W2], 128, 64, (u16*)(ws + WS_WC2T), 64, nullptr, scr, lane, it0, gw, NGW);
  conv_job<MapId>(p.in[I_C_W2] + 128 * 64, 128, 64, (u16*)(ws + WS_WC2T) + 64 * 128, 64, nullptr, scr, lane, it0, gw, NGW);
  {
    const int gt = blockIdx.x * 512 + tid, NGT = gridDim.x * 512;
    f32x2* r64 = (f32x2*)(ws + WS_ROPE64); f32x2* r32 = (f32x2*)(ws + WS_ROPE32);
    for (int e = gt; e < SEQ * 48; e += NGT) {
      const int pos = e / 48, j = e % 48;
      const bool is64 = j < 32; const int i = is64 ? j : j - 32;
      const float ex = is64 ? (float)(2 * i) / 64.f : (float)(2 * i) / 32.f;
      const float inv = exp2f(-ex * 13.287712379549449f);
      const float ang = (float)pos * inv;
      const double rev = (double)ang * 0.15915494309189535; const float fr = (float)(rev - floor(rev));
      f32x2 cs; cs.x = __builtin_amdgcn_cosf(fr); cs.y = __builtin_amdgcn_sinf(fr);
      if (is64) r64[pos * 32 + i] = cs; else r32[pos * 16 + i] = cs;
    }
  }
  if (gw < 256) {
    const int j = gw >> 7, n = gw & 127;
    const float* pe = p.in[I_C_PE] + j * 2048; const float* w1 = p.in[I_C_W1] + (size_t)j * 2048 * 128 + n;
    float s = 0.f;
#pragma unroll 8
    for (int k = lane; k < 2048; k += 64) s += pe[k] * w1[(size_t)k * 128];
    s = wave_sum(s);
    if (lane == 0) ((float*)(ws + WS_CBIAS))[gw] = s;
  }
  {
    const float* x = p.in[I_X]; u16* xb = (u16*)(ws + WS_XB); float* ssq0 = (float*)(ws + WS_SSQ0);
    for (int m0 = gw * 4; m0 < T; m0 += NGW * 4) {
      f32x4 v[4][4]; float s[4];
#pragma unroll
      for (int r = 0; r < 4; ++r) { const f32x4* xr = (const f32x4*)(x + (size_t)(m0 + r) * DM) + lane;
#pragma unroll
        for (int j = 0; j < 4; ++j) v[r][j] = xr[64 * j]; }
#pragma unroll
      for (int r = 0; r < 4; ++r) { s[r] = 0.f;
#pragma unroll
        for (int j = 0; j < 4; ++j) s[r] += v[r][j].x * v[r][j].x + v[r][j].y * v[r][j].y + v[r][j].z * v[r][j].z + v[r][j].w * v[r][j].w; }
#pragma unroll
      for (int o = 1; o < 64; o <<= 1) {
#pragma unroll
        for (int r = 0; r < 4; ++r) s[r] += __shfl_xor(s[r], o); }
#pragma unroll
      for (int r = 0; r < 4; ++r) { u32x2* o = (u32x2*)(xb + (size_t)(m0 + r) * DM) + lane;
#pragma unroll
        for (int j = 0; j < 4; ++j) { u32x2 w; w.x = cvtpk(v[r][j].x, v[r][j].y); w.y = cvtpk(v[r][j].z, v[r][j].w); o[64 * j] = w; }
        if (lane == 0) ssq0[m0 + r] = s[r]; }
    }
  }
}

namespace pg8 {
#define PG8_LAS __attribute__((address_space(3)))
typedef unsigned short bf16_t;
typedef short bf16x8 __attribute__((ext_vector_type(8)));
typedef float f32x4 __attribute__((ext_vector_type(4)));
typedef unsigned u32x4 __attribute__((ext_vector_type(4)));
constexpr int BM = 256, BK = 64, HALF = 128, HTB = HALF * BK * 2  , STAGE_BYTES = 8 * HTB, NXCD = 8, WGM = 8;

__host__ __device__ __forceinline__ int lds_byte(int r, int c) { const int st = (r >> 4) * 2 + (c >> 5), rr = r & 15, cc = c & 31, ob = rr * 64 + cc * 2; return st * 1024 + (ob ^ (((ob >> 9) & 1) << 5)); }
__host__ __device__ __forceinline__ void stage_rc(int b, int& R, int& C) { const int st = b / 1024, sb = b % 1024, swz = sb ^ (((sb >> 9) & 1) << 5); R = (st >> 1) * 16 + swz / 64; C = (st & 1) * 32 + (swz % 64) / 2; }
__host__ __device__ __forceinline__ int perm32(int rho) { const int n = rho >> 4, i = rho & 15; return 8 * (i >> 2) + 4 * n + (i & 3); }

struct Unit { int pm, pn; };
struct Gemm { const bf16_t* A; const bf16_t* Bt; int M, N, K; };

struct StaticOrder {
    int nM, nN, nwg, G, c;
    __host__ __device__ void init(int M, int N, int G_, int c_) { nM = M / BM; nN = N / BM; nwg = nM * nN; G = G_; c = c_; }
    __host__ __device__ bool next(int i, Unit& u) const {
        const long L = (long)i * G + c; if (L >= nwg) return false;
        int wgid = (int)L; { const int q = nwg / NXCD, r = nwg % NXCD, xcd = wgid % NXCD, off = wgid / NXCD; wgid = (xcd < r ? xcd * (q + 1) : r * (q + 1) + (xcd - r) * q) + off; }
        const int nig = WGM * nN, gid = wgid / nig, fm = gid * WGM, gsz = (nM - fm) < WGM ? (nM - fm) : WGM;
        u.pm = fm + ((wgid % nig) % gsz); u.pn = (wgid % nig) / gsz; return true;
    }
    __device__ __forceinline__ void a_ready(const Unit&) const {}
    __device__ __forceinline__ void done(const Unit&) const {}
};


template <class Epi, class Sched, bool ALIGN_EPI = false, bool SP2 = false>
__device__ __forceinline__ void gemm_phase(PG8_LAS unsigned char* lds, const Gemm g, const Sched& S, const Epi& E) {
    const int tid = threadIdx.x, wid = __builtin_amdgcn_readfirstlane(tid >> 6), lane = tid & 63, wr = wid >> 2, wc = wid & 3, fr = lane & 15, fq = lane >> 4;
    const int K = g.K, nt = K / BK;
    unsigned voffA[2], voffB[2];
#pragma unroll
    for (int i = 0; i < 2; ++i) { int R, C; stage_rc(tid * 16 + i * 8192, R, C); const int Rb = Epi::PERM ? ((R & ~31) + perm32(R & 31)) : R;
        voffA[i] = (unsigned)(R * K + C) * 2u; voffB[i] = (unsigned)(Rb * K + C) * 2u; }
    const size_t kstep = (size_t)(BK * 2);
    const size_t hstep = (size_t)HALF * K * 2;
    const size_t tstep = 2 * hstep;
    const unsigned ldsw = (unsigned)wid * 1024u;
    const int aoff = lds_byte(wr * 64 + fr, fq * 8), boff = lds_byte(wc * 32 + fr, fq * 8);
#define PG8_SA(b, h) (((b) * 2 + (h)) * HTB)
#define PG8_SB(b, h) ((4 + (b) * 2 + (h)) * HTB)
#define PG8_STAGE(bufoff, gbase, voff) do { _Pragma("unroll") for (int _i = 0; _i < 2; ++_i) \
        __builtin_amdgcn_global_load_lds((const unsigned*)((const char*)(gbase) + (voff)[_i]), (PG8_LAS unsigned*)(lds + (bufoff) + ldsw + _i * 8192), 16, 0, 0); } while (0)
#define PG8_LDA(dst, b, h) do { _Pragma("unroll") for (int m = 0; m < 4; ++m) _Pragma("unroll") for (int k = 0; k < 2; ++k) dst[m][k] = *(const PG8_LAS bf16x8*)(lds + PG8_SA(b, h) + aoff + m * 2048 + k * 1024); } while (0)
#define PG8_LDB(dst, b, h) do { _Pragma("unroll") for (int n = 0; n < 2; ++n) _Pragma("unroll") for (int k = 0; k < 2; ++k) dst[n][k] = *(const PG8_LAS bf16x8*)(lds + PG8_SB(b, h) + boff + n * 2048 + k * 1024); } while (0)
#define PG8_MMA(ai, bj, At, Bt) do { __builtin_amdgcn_s_setprio(1); _Pragma("unroll") for (int m = 0; m < 4; ++m) _Pragma("unroll") for (int n = 0; n < 2; ++n) _Pragma("unroll") for (int k = 0; k < 2; ++k) \
        acc[ai][bj][m][n] = __builtin_amdgcn_mfma_f32_16x16x32_bf16(Bt[n][k], At[m][k], acc[ai][bj][m][n], 0, 0, 0); __builtin_amdgcn_s_setprio(0); } while (0)
#define PG8_WAIT_V(n) asm volatile("s_waitcnt vmcnt(" #n ")" ::: "memory")
#define PG8_WAIT_L(n) asm volatile("s_waitcnt lgkmcnt(" #n ")" ::: "memory")
#define PG8_BAR __builtin_amdgcn_s_barrier()
#define PG8_SCHED __builtin_amdgcn_sched_barrier(0)
    Unit cur, nxt; int ui = 0;
    if (!S.next(0, cur)) return;
    f32x4 acc[2][2][4][2];
#pragma unroll
    for (int a = 0; a < 2; ++a)
#pragma unroll
        for (int b = 0; b < 2; ++b)
#pragma unroll
            for (int m = 0; m < 4; ++m)
#pragma unroll
                for (int n = 0; n < 2; ++n) acc[a][b][m][n] = (f32x4){0.f, 0.f, 0.f, 0.f};
    bf16x8 At[4][2], B0[2][2], B1[2][2];
    const char* cA = (const char*)g.A + (size_t)cur.pm * tstep; const char* cB = (const char*)g.Bt + (size_t)cur.pn * tstep;
    S.a_ready(cur);
    if constexpr (SP2) {
        PG8_STAGE(PG8_SB(0, 0), cB, voffB); PG8_STAGE(PG8_SB(0, 1), cB + hstep, voffB); PG8_STAGE(PG8_SA(0, 0), cA, voffA); PG8_STAGE(PG8_SA(0, 1), cA + hstep, voffA);
        if (wr == 1) PG8_BAR;
        PG8_WAIT_V(2); PG8_BAR;
        PG8_STAGE(PG8_SB(1, 0), cB + kstep, voffB); PG8_STAGE(PG8_SA(1, 0), cA + kstep, voffA); PG8_STAGE(PG8_SB(1, 1), cB + hstep + kstep, voffB);
        PG8_WAIT_V(6); PG8_BAR;
    } else {
        PG8_STAGE(PG8_SB(0, 0), cB, voffB); PG8_STAGE(PG8_SA(0, 0), cA, voffA); PG8_STAGE(PG8_SB(0, 1), cB + hstep, voffB); PG8_STAGE(PG8_SA(0, 1), cA + hstep, voffA);
        if (wr == 1) PG8_BAR;
        PG8_WAIT_V(4); PG8_BAR;
        PG8_STAGE(PG8_SB(1, 0), cB + kstep, voffB); PG8_STAGE(PG8_SA(1, 0), cA + kstep, voffA); PG8_STAGE(PG8_SB(1, 1), cB + hstep + kstep, voffB);
        PG8_WAIT_V(6); PG8_BAR;
    }
    for (;;) {
        const bool has_next = S.next(ui + 1, nxt);
        const char* nA = has_next ? (const char*)g.A + (size_t)nxt.pm * tstep : cA; const char* nB = has_next ? (const char*)g.Bt + (size_t)nxt.pn * tstep : cB;
        for (int t = 0; t < nt; t += 2) {
            const bool last = (t == nt - 2);
            const char* a1 = cA + (size_t)(t + 1) * kstep;
            const char* a2 = last ? nA : cA + (size_t)(t + 2) * kstep; const char* b2 = last ? nB : cB + (size_t)(t + 2) * kstep;
            const char* a3 = a2 + kstep; const char* b3 = b2 + kstep;
            if (last && has_next) S.a_ready(nxt);
            if constexpr (SP2) {
            PG8_LDB(B0, 0, 0); PG8_LDB(B1, 0, 1); PG8_SCHED; PG8_LDA(At, 0, 0); PG8_STAGE(PG8_SA(1, 1), a1 + hstep, voffA);
            PG8_WAIT_V(8); PG8_WAIT_L(0); PG8_BAR; PG8_MMA(0, 0, At, B0); PG8_MMA(0, 1, At, B1); PG8_BAR; PG8_SCHED;
            PG8_LDA(At, 0, 1); PG8_STAGE(PG8_SB(0, 0), b2, voffB); PG8_STAGE(PG8_SB(0, 1), b2 + hstep, voffB); PG8_STAGE(PG8_SA(0, 0), a2, voffA);
            PG8_WAIT_V(8); PG8_WAIT_L(0); PG8_BAR; PG8_MMA(1, 0, At, B0); PG8_MMA(1, 1, At, B1); PG8_BAR; PG8_SCHED;
            PG8_LDB(B0, 1, 0); PG8_LDB(B1, 1, 1); PG8_SCHED; PG8_LDA(At, 1, 0); PG8_STAGE(PG8_SA(0, 1), a2 + hstep, voffA);
            PG8_WAIT_V(8); PG8_WAIT_L(0); PG8_BAR; PG8_MMA(0, 0, At, B0); PG8_MMA(0, 1, At, B1); PG8_BAR; PG8_SCHED;
            PG8_LDA(At, 1, 1); PG8_STAGE(PG8_SB(1, 0), b3, voffB); PG8_STAGE(PG8_SB(1, 1), b3 + hstep, voffB); PG8_STAGE(PG8_SA(1, 0), a3, voffA);
            PG8_WAIT_V(8); PG8_WAIT_L(0); PG8_BAR; PG8_MMA(1, 0, At, B0); PG8_MMA(1, 1, At, B1); PG8_BAR; PG8_SCHED;
            } else {
            PG8_LDB(B0, 0, 0); PG8_SCHED; PG8_LDA(At, 0, 0); PG8_STAGE(PG8_SA(1, 1), a1 + hstep, voffA);
            PG8_WAIT_L(8); PG8_BAR; PG8_WAIT_L(0); PG8_MMA(0, 0, At, B0); PG8_BAR; PG8_SCHED;
            PG8_LDB(B1, 0, 1); PG8_STAGE(PG8_SB(0, 0), b2, voffB);
            PG8_BAR; PG8_WAIT_L(0); PG8_MMA(0, 1, At, B1); PG8_BAR;
            PG8_LDA(At, 0, 1); PG8_STAGE(PG8_SA(0, 0), a2, voffA);
            PG8_BAR; PG8_WAIT_L(0); PG8_MMA(1, 0, At, B0); PG8_BAR; PG8_SCHED;
            PG8_STAGE(PG8_SB(0, 1), b2 + hstep, voffB);
            PG8_WAIT_V(6); PG8_BAR; PG8_MMA(1, 1, At, B1); PG8_BAR;
            PG8_LDB(B0, 1, 0); PG8_SCHED; PG8_LDA(At, 1, 0); PG8_STAGE(PG8_SA(0, 1), a2 + hstep, voffA);
            PG8_WAIT_L(8); PG8_BAR; PG8_WAIT_L(0); PG8_MMA(0, 0, At, B0); PG8_BAR; PG8_SCHED;
            PG8_LDB(B1, 1, 1); PG8_STAGE(PG8_SB(1, 0), b3, voffB);
            PG8_BAR; PG8_WAIT_L(0); PG8_MMA(0, 1, At, B1); PG8_BAR;
            PG8_LDA(At, 1, 1); PG8_STAGE(PG8_SA(1, 0), a3, voffA);
            PG8_BAR; PG8_WAIT_L(0); PG8_MMA(1, 0, At, B0); PG8_BAR; PG8_SCHED;
            PG8_STAGE(PG8_SB(1, 1), b3 + hstep, voffB);
            PG8_WAIT_V(6); PG8_BAR; PG8_MMA(1, 1, At, B1); PG8_BAR;
            }
        }
        if constexpr (ALIGN_EPI) { if (wr == 0) PG8_BAR; }
        if constexpr (!Epi::AFTER_DRAIN) { E(acc, cur, wr, wc, fr, fq); S.done(cur); }
        if (!has_next) break;
#pragma unroll
        for (int a = 0; a < 2; ++a)
#pragma unroll
            for (int b = 0; b < 2; ++b)
#pragma unroll
                for (int m = 0; m < 4; ++m)
#pragma unroll
                    for (int n = 0; n < 2; ++n) acc[a][b][m][n] = (f32x4){0.f, 0.f, 0.f, 0.f};
        cur = nxt; cA = nA; cB = nB; ++ui;
        if constexpr (ALIGN_EPI) { if (wr == 1) PG8_BAR; }
    }
    PG8_WAIT_V(0);
    if constexpr (!ALIGN_EPI) { if (wr == 0) PG8_BAR; }
    PG8_BAR;
    if constexpr (Epi::AFTER_DRAIN) { E.fused(acc, cur, wr, wc, fr, fq, lds, wid, lane); S.done(cur); }
#undef PG8_SA
#undef PG8_SB
#undef PG8_STAGE
#undef PG8_LDA
#undef PG8_LDB
#undef PG8_MMA
#undef PG8_WAIT_V
#undef PG8_WAIT_L
#undef PG8_BAR
#undef PG8_SCHED
}
}
struct RowVals { float v[4][4]; };

#define COLB(ni, fq) (32 * ((ni) >> 1) + 8 * (fq) + 4 * ((ni) & 1))
__device__ __forceinline__ void ld_gain16(const float* __restrict__ g, int fq, float (&gn)[4][4]) {
#pragma unroll
  for (int ni = 0; ni < 4; ++ni) { const f32x4 t = *(const f32x4*)(g + COLB(ni, fq));
#pragma unroll
    for (int r = 0; r < 4; ++r) gn[ni][r] = t[r]; }
}
__device__ __forceinline__ void rmsnorm64(RowVals& x, const float (&gn)[4][4]) {
  float ss = 0.f;
#pragma unroll
  for (int ni = 0; ni < 4; ++ni)
#pragma unroll
    for (int r = 0; r < 4; ++r) ss += x.v[ni][r] * x.v[ni][r];
  ss = rsum4(ss);
  const float rstd = __builtin_amdgcn_rsqf(ss * (1.f / 64.f) + EPS);
#pragma unroll
  for (int ni = 0; ni < 4; ++ni)
#pragma unroll
    for (int r = 0; r < 4; ++r) x.v[ni][r] *= rstd * gn[ni][r];
}
__device__ __forceinline__ void rope64_apply(RowVals& x, const f32x2* __restrict__ tab_pos, int fq) {
#pragma unroll
  for (int ni = 0; ni < 2; ++ni) {
    const f32x4 t0 = *(const f32x4*)(tab_pos + COLB(ni, fq)), t1 = *(const f32x4*)(tab_pos + COLB(ni, fq) + 2);
    const float cs[4] = {t0.x, t0.z, t1.x, t1.z}, sn[4] = {t0.y, t0.w, t1.y, t1.w};
#pragma unroll
    for (int r = 0; r < 4; ++r) { const float a = x.v[ni][r], b = x.v[ni + 2][r]; x.v[ni][r] = a * cs[r] - b * sn[r]; x.v[ni + 2][r] = b * cs[r] + a * sn[r]; }
  }
}
__device__ __forceinline__ void norm_rope32(RowVals& x, int nA, const float* __restrict__ g32, const f32x2* __restrict__ tab_pos, int fq, float scale) {
  float ss = 0.f;
#pragma unroll
  for (int r = 0; r < 4; ++r) ss += x.v[nA][r] * x.v[nA][r] + x.v[nA + 1][r] * x.v[nA + 1][r];
  ss = rsum4(ss);
  const float rstd = __builtin_amdgcn_rsqf(ss * (1.f / 32.f) + EPS) * scale;
  const f32x4 ga = *(const f32x4*)(g32 + 4 * fq), gb = *(const f32x4*)(g32 + 16 + 4 * fq);
  const f32x4 t0 = *(const f32x4*)(tab_pos + 4 * fq), t1 = *(const f32x4*)(tab_pos + 4 * fq + 2);
  const float cs[4] = {t0.x, t0.z, t1.x, t1.z}, sn[4] = {t0.y, t0.w, t1.y, t1.w};
#pragma unroll
  for (int r = 0; r < 4; ++r) { const float a = x.v[nA][r] * rstd * ga[r], b = x.v[nA + 1][r] * rstd * gb[r]; x.v[nA][r] = a * cs[r] - b * sn[r]; x.v[nA + 1][r] = b * cs[r] + a * sn[r]; }
}
__device__ __forceinline__ void st_bf16_row(u16* dst  , const RowVals& x, int fq, float scale = 1.f) {
#pragma unroll
  for (int bj = 0; bj < 2; ++bj) { u32x4 w; w.x = cvtpk(x.v[2 * bj][0] * scale, x.v[2 * bj][1] * scale); w.y = cvtpk(x.v[2 * bj][2] * scale, x.v[2 * bj][3] * scale);
    w.z = cvtpk(x.v[2 * bj + 1][0] * scale, x.v[2 * bj + 1][1] * scale); w.w = cvtpk(x.v[2 * bj + 1][2] * scale, x.v[2 * bj + 1][3] * scale); *(u32x4*)(dst + 32 * bj + 8 * fq) = w; }
}

__device__ __forceinline__ void st_fp8_row(unsigned char* dst  , const RowVals& x, int fq) {
#pragma unroll
  for (int bj = 0; bj < 2; ++bj) { u32x2 w; int a = 0, b = 0;
    a = __builtin_amdgcn_cvt_pk_fp8_f32(x.v[2 * bj][0], x.v[2 * bj][1], a, false); a = __builtin_amdgcn_cvt_pk_fp8_f32(x.v[2 * bj][2], x.v[2 * bj][3], a, true);
    b = __builtin_amdgcn_cvt_pk_fp8_f32(x.v[2 * bj + 1][0], x.v[2 * bj + 1][1], b, false); b = __builtin_amdgcn_cvt_pk_fp8_f32(x.v[2 * bj + 1][2], x.v[2 * bj + 1][3], b, true);
    w.x = (unsigned)a; w.y = (unsigned)b; *(u32x2*)(dst + 32 * bj + 8 * fq) = w; }
}

template <int LAYER> struct EpiProj {
  unsigned char* ws; const float* const* in;
  __device__ __forceinline__ void operator()(int row0, int g, const f32x4 (&acc)[4][4], int fr, int fq) const {
    const f32x2* rope64 = (const f32x2*)(ws + WS_ROPE64); const f32x2* rope32 = (const f32x2*)(ws + WS_ROPE32);
    int kind; unsigned char* dst8 = nullptr; u16* dst = nullptr; int ld = 0; const float* gain = nullptr; float scale = 1.f; float* fdst = nullptr; float* ssqdst = nullptr; int ssqld = 0;
    if (LAYER == 0) {
      if (g < 8) { kind = 1; dst = (u16*)(ws + L0_QA) + g * 64; ld = 512; gain = in[I_A_QKN]; scale = QS64; }
      else if (g < 10) { kind = 8; dst8 = ws + L0_KVA + (g - 8) * 64; gain = in[I_A_QKN] + 64; }
      else if (g < 12) { kind = 9; dst8 = ws + L0_KVA + (g - 8) * 64; }
      else if (g < 16) { kind = 2; dst = (u16*)(ws + L0_QI) + (g - 12) * 64; ld = 256; }
      else if (g < 17) { kind = 1; dst = (u16*)(ws + L0_KI); ld = 64; gain = in[I_A_KIDXN]; }
      else if (g < 18) { kind = 4; fdst = (float*)(ws + L0_WI); }
      else if (g < 26) { kind = 3; dst = (u16*)(ws + WS_MIX) + (g - 18) * 64; ld = 1024; }
      else if (g < 34) { kind = 1; dst = (u16*)(ws + L0_QB) + (g - 26) * 64; ld = 512; gain = in[I_B_QKN]; scale = QS64; }
      else if (g < 36) { kind = 1; dst = (u16*)(ws + L0_KVB) + (g - 34) * 64; ld = 256; gain = in[I_B_QKN] + 64; }
      else if (g < 38) { kind = 0; dst = (u16*)(ws + L0_KVB) + 128 + (g - 36) * 64; ld = 256; }
      else { kind = 3; dst = (u16*)(ws + WS_MIX) + 512 + (g - 38) * 64; ld = 1024; }
    } else {
      if (g < 8) { kind = 1; dst = (u16*)(ws + L1_QC) + g * 64; ld = 512; gain = in[I_C_QN]; scale = QS64; }
      else if (g < 10) { kind = 0; dst = (u16*)(ws + L1_KCR) + (g - 8) * 64; ld = 128; }
      else if (g < 12) { kind = 0; dst = (u16*)(ws + L1_VCR) + (g - 10) * 64; ld = 128; }
      else if (g < 14) { kind = 1; dst = (u16*)(ws + L1_KVS) + (g - 12) * 64; ld = 256; gain = in[I_C_KN] + 64; }
      else if (g < 16) { kind = 0; dst = (u16*)(ws + L1_KVS) + 128 + (g - 14) * 64; ld = 256; }
      else if (g < 18) { kind = 1; dst = (u16*)(ws + L1_KVW) + (g - 16) * 64; ld = 256; gain = in[I_C_KN] + 128; }
      else if (g < 20) { kind = 0; dst = (u16*)(ws + L1_KVW) + 128 + (g - 18) * 64; ld = 256; }
      else if (g < 21) { kind = 5; fdst = (float*)(ws + L1_GATES); }
      else if (g < 29) { kind = 3; dst = (u16*)(ws + WS_MIX) + (g - 21) * 64; ld = 1024; }
      else if (g < 33) { kind = 6; dst = (u16*)(ws + L1_CQ) + (g - 29) * 64; ld = 256; ssqdst = (float*)(ws + L1_SSQQ) + (g - 29); ssqld = 4; }
      else if (g < 35) { kind = 6; dst = (u16*)(ws + L1_CKV) + (g - 33) * 64; ld = 128; ssqdst = (float*)(ws + L1_SSQKV) + (g - 33); ssqld = 2; }
      else if (g < 36) { kind = 7; dst = (u16*)(ws + L1_KROPE); ld = 32; gain = in[I_D_ROPEN] + 32; }
      else { kind = 3; dst = (u16*)(ws + WS_MIX) + 512 + (g - 36) * 64; ld = 1024; }
    }
    float gn[4][4];
    if (kind == 1 || kind == 8) ld_gain16(gain, fq, gn);
#pragma unroll
    for (int mi = 0; mi < 4; ++mi) {
      const int t = row0 + mi * 16 + fr, pos = t & (SEQ - 1);
      float rstd;
      if (LAYER == 0) rstd = __builtin_amdgcn_rsqf(((const float*)(ws + WS_SSQ0))[t] * (1.f / 1024.f) + EPS);
      else { const f32x4* sp = (const f32x4*)((const float*)(ws + WS_SSQ1P) + (size_t)t * 16); const f32x4 a = sp[0], b = sp[1], c = sp[2], d = sp[3];
             const float s = (a.x + a.y + a.z + a.w) + (b.x + b.y + b.z + b.w) + (c.x + c.y + c.z + c.w) + (d.x + d.y + d.z + d.w); rstd = __builtin_amdgcn_rsqf(s * (1.f / 1024.f) + EPS); }
      RowVals x;
#pragma unroll
      for (int ni = 0; ni < 4; ++ni)
#pragma unroll
        for (int r = 0; r < 4; ++r) x.v[ni][r] = acc[mi][ni][r] * rstd;
      if (kind == 0) { st_bf16_row(dst + (size_t)t * ld, x, fq); }
      else if (LAYER == 0 && kind == 8) { rmsnorm64(x, gn); rope64_apply(x, rope64 + pos * 32, fq); st_fp8_row(dst8 + (size_t)t * 256, x, fq); }
      else if (LAYER == 0 && kind == 9) { st_fp8_row(dst8 + (size_t)t * 256, x, fq); }
      else if (kind == 1) { rmsnorm64(x, gn); rope64_apply(x, rope64 + pos * 32, fq); st_bf16_row(dst + (size_t)t * ld, x, fq, scale); }
      else if (kind == 2) { rope64_apply(x, rope64 + pos * 32, fq); st_bf16_row(dst + (size_t)t * ld, x, fq); }
      else if (kind == 3) {
#pragma unroll
        for (int ni = 0; ni < 4; ++ni)
#pragma unroll
          for (int r = 0; r < 4; ++r) x.v[ni][r] = silu_f(x.v[ni][r]);
        st_bf16_row(dst + (size_t)t * ld, x, fq);
      } else if (kind == 4) { if (fq == 0) *(f32x4*)(fdst + (size_t)t * 4) = (f32x4){x.v[0][0], x.v[0][1], x.v[0][2], x.v[0][3]}; }
      else if (kind == 5) {
        if (fq < 3) {
          *(f32x4*)(fdst + (size_t)t * 24 + 8 * fq) = (f32x4){sigmoid_f(x.v[0][0]), sigmoid_f(x.v[0][1]), sigmoid_f(x.v[0][2]), sigmoid_f(x.v[0][3])};
          *(f32x4*)(fdst + (size_t)t * 24 + 8 * fq + 4) = (f32x4){sigmoid_f(x.v[1][0]), sigmoid_f(x.v[1][1]), sigmoid_f(x.v[1][2]), sigmoid_f(x.v[1][3])};
        }
      } else if (kind == 6) {
        float ss = 0.f;
#pragma unroll
        for (int ni = 0; ni < 4; ++ni)
#pragma unroll
          for (int r = 0; r < 4; ++r) ss += x.v[ni][r] * x.v[ni][r];
        ss = rsum4(ss);
        if (fq == 0) ssqdst[(size_t)t * ssqld] = ss;
        st_bf16_row(dst + (size_t)t * ld, x, fq);
      } else {
        norm_rope32(x, 0, gain, rope32 + pos * 16, fq, 1.f);
        u32x2 w0, w1; w0.x = cvtpk(x.v[0][0], x.v[0][1]); w0.y = cvtpk(x.v[0][2], x.v[0][3]); w1.x = cvtpk(x.v[1][0], x.v[1][1]); w1.y = cvtpk(x.v[1][2], x.v[1][3]);
        *(u32x2*)(dst + (size_t)t * 32 + 4 * fq) = w0; *(u32x2*)(dst + (size_t)t * 32 + 16 + 4 * fq) = w1;
      }
    }
  }
};

template <int WHICH> struct EpiUp {
  unsigned char* ws; const float* const* in;
  __device__ __forceinline__ void operator()(int row0, int g, const f32x4 (&acc)[4][4], int fr, int fq) const {
    const f32x2* rope32 = (const f32x2*)(ws + WS_ROPE32);
    const bool nope = g < 8;
#pragma unroll
    for (int mi = 0; mi < 4; ++mi) {
      const int t = row0 + mi * 16 + fr, pos = t & (SEQ - 1);
      float gn[4][4];
      if (nope) ld_gain16(in[I_D_NOPEN] + (WHICH == 0 ? 0 : 64), fq, gn);
      asm volatile("" ::: "memory");
      float rstd;
      if (WHICH == 0) { const f32x4 s = *(const f32x4*)((const float*)(ws + L1_SSQQ) + (size_t)t * 4); rstd = __builtin_amdgcn_rsqf((s.x + s.y + s.z + s.w) * (1.f / 256.f) + EPS); }
      else { const f32x2 s = *(const f32x2*)((const float*)(ws + L1_SSQKV) + (size_t)t * 2); rstd = __builtin_amdgcn_rsqf((s.x + s.y) * (1.f / 128.f) + EPS); }
      RowVals x;
#pragma unroll
      for (int ni = 0; ni < 4; ++ni)
#pragma unroll
        for (int r = 0; r < 4; ++r) x.v[ni][r] = acc[mi][ni][r] * rstd;
      if (WHICH == 0) {
        u16* qm = (u16*)(ws + L1_QM) + (size_t)t * 768;
        if (nope) { rmsnorm64(x, gn); st_bf16_row(qm + g * 96, x, fq, QS96); }
        else {
#pragma unroll
          for (int hh = 0; hh < 2; ++hh) {
            norm_rope32(x, 2 * hh, in[I_D_ROPEN], rope32 + pos * 16, fq, QS96);
            u16* d = qm + (2 * (g - 8) + hh) * 96 + 64;
            u32x2 w0, w1; w0.x = cvtpk(x.v[2 * hh][0], x.v[2 * hh][1]); w0.y = cvtpk(x.v[2 * hh][2], x.v[2 * hh][3]);
            w1.x = cvtpk(x.v[2 * hh + 1][0], x.v[2 * hh + 1][1]); w1.y = cvtpk(x.v[2 * hh + 1][2], x.v[2 * hh + 1][3]);
            *(u32x2*)(d + 4 * fq) = w0; *(u32x2*)(d + 16 + 4 * fq) = w1;
          }
        }
      } else {
        if (nope) { rmsnorm64(x, gn); st_bf16_row((u16*)(ws + L1_KN) + (size_t)t * 512 + g * 64, x, fq); }
        else st_bf16_row((u16*)(ws + L1_VM) + (size_t)t * 512 + (g - 8) * 64, x, fq);
      }
    }
  }
};

template <int LAYER> struct EpiOut {
  unsigned char* ws; const float* x; float* out;
  __device__ __forceinline__ void operator()(int row0, int g, const f32x4 (&acc)[4][4], int fr, int fq) const {
    const float* base = (LAYER == 0 ? x : out);
#pragma unroll
    for (int mp = 0; mp < 2; ++mp) {
      f32x4 bv[2][4];
#pragma unroll
      for (int mm = 0; mm < 2; ++mm) { const int t = row0 + (2 * mp + mm) * 16 + fr; const size_t off = (size_t)t * DM + g * 64;
#pragma unroll
        for (int ni = 0; ni < 4; ++ni) bv[mm][ni] = *(const f32x4*)(base + off + COLB(ni, fq)); }
#pragma unroll
      for (int mm = 0; mm < 2; ++mm) {
        const int mi = 2 * mp + mm, t = row0 + mi * 16 + fr; const size_t off = (size_t)t * DM + g * 64;
        float ss = 0.f;
#pragma unroll
        for (int ni = 0; ni < 4; ++ni) {
          const int cb = COLB(ni, fq);
          const f32x4 o = bv[mm][ni] + acc[mi][ni];
          *(f32x4*)(out + off + cb) = o;
          if (LAYER == 0) {
            ss += o.x * o.x + o.y * o.y + o.z * o.z + o.w * o.w;
            u32x2 w; w.x = cvtpk(o.x, o.y); w.y = cvtpk(o.z, o.w); *(u32x2*)((u16*)(ws + WS_XB) + off + cb) = w;
          }
        }
        if (LAYER == 0) { ss = rsum4(ss); if (fq == 0) ((float*)(ws + WS_SSQ1P))[(size_t)t * 16 + g] = ss; }
      }
    }
  }
};

struct EpiNull {
  float* sink;
  __device__ __forceinline__ void operator()(int row0, int g, const f32x4 (&acc)[4][4], int fr, int fq) const {
    float s = 0.f;
#pragma unroll
    for (int mi = 0; mi < 4; ++mi)
#pragma unroll
      for (int ni = 0; ni < 4; ++ni) s += acc[mi][ni][0] + acc[mi][ni][1] + acc[mi][ni][2] + acc[mi][ni][3];
    if (s == 123.456f) sink[row0 + fr] = s;
  }
};
template <class E> struct Pg8Epi {
  static constexpr bool PERM = false, AFTER_DRAIN = false;
  E e; int ngroups;
  __device__ __forceinline__ void operator()(const f32x4 (&acc)[2][2][4][2], const pg8::Unit& u, int wr, int wc, int fr, int fq) const {
    const int g = u.pn * 4 + wc;
    if (g >= ngroups) return;
#pragma unroll
    for (int ai = 0; ai < 2; ++ai) {
      f32x4 a4[4][4];
#pragma unroll
      for (int m = 0; m < 4; ++m)
#pragma unroll
        for (int ni = 0; ni < 4; ++ni) a4[m][ni] = acc[ai][ni >> 1][m][ni & 1];
      e(u.pm * 256 + ai * 128 + wr * 64, g, a4, fr, fq);
    }
  }
};
template <class E> __device__ __forceinline__ void run_gemm(char* lds, const u16* A, const u16* Bt, int M, int N, int K, const E& e, int ngroups) {
  asm volatile("" : "+s"(K));
  pg8::Gemm g{A, Bt, M, N, K}; pg8::StaticOrder S; S.init(M, N, (int)gridDim.x, (int)blockIdx.x);
  Pg8Epi<E> pe{e, ngroups};
  pg8::gemm_phase<Pg8Epi<E>, pg8::StaticOrder, true, true>((PG8_LAS unsigned char*)lds, g, S, pe);
}
constexpr int CH_K = 0, CH_V = 8192, CH_R = 16384, CH_BYTES = 16384, CH_BYTES_ROPE = 24576;

__device__ __forceinline__ unsigned kimg_off(int key, int c) { return (unsigned)(key * 128 + ((c ^ ((key >> 1) & 7)) << 4)); }
__device__ __forceinline__ unsigned vimg_off(int key, int c) { return (unsigned)(key * 128 + ((((c >> 1) ^ ((key >> 1) & 3)) << 5) | ((c & 1) << 4))); }
__device__ __forceinline__ unsigned vimg32_off(int key, int c) { return (unsigned)(key * 128 + ((((c >> 1) ^ (((key >> 1) & 1) << 1)) << 5) | ((c & 1) << 4))); }

struct ChunkRegs { u32x4 k, v, r; };
template <bool ROPE>
__device__ __forceinline__ void chunk_fetch(ChunkRegs& cr, const u16* __restrict__ Kg, int ldk, const u16* __restrict__ Vg, int ldv, const u16* __restrict__ Rg, int k0, int kmax  , int tid) {
  asm volatile("" : "+v"(tid));
  int key = k0 + (tid >> 3); if (key > kmax) key = kmax;
  cr.k = *(const u32x4*)(Kg + (size_t)key * ldk + (tid & 7) * 8);
  cr.v = *(const u32x4*)(Vg + (size_t)key * ldv + (tid & 7) * 8);
  if (ROPE) { if (tid < 256) { int kr = k0 + (tid >> 2); if (kr > kmax) kr = kmax; cr.r = *(const u32x4*)(Rg + (size_t)kr * 32 + (tid & 3) * 8); } }
}
template <bool ROPE, bool V32 = false>
__device__ __forceinline__ void chunk_store(const ChunkRegs& cr, char* buf, int tid) {
  asm volatile("" : "+v"(tid));
  const int key = tid >> 3, c = tid & 7;
  *(u32x4*)(buf + CH_K + kimg_off(key, c)) = cr.k;
  *(u32x4*)(buf + CH_V + (V32 ? vimg32_off(key, c) : vimg_off(key, c))) = cr.v;
  if (ROPE) { if (tid < 256) *(u32x4*)(buf + CH_R + kimg_off(tid >> 2, tid & 3)) = cr.r; }
}

constexpr float ATTN_THR = 8.f;
template <int NT> struct AttnAcc { f32x4 o[NT][4]; f32x4 lv[NT]; f32x4 nsh[NT]; float m[NT], l[NT]; };
template <int NT> __device__ __forceinline__ void acc_init(AttnAcc<NT>& st, float m0, float l0) {
#pragma unroll
  for (int nt = 0; nt < NT; ++nt) { st.m[nt] = m0; st.l[nt] = l0; st.lv[nt] = (f32x4){0.f, 0.f, 0.f, 0.f}; st.nsh[nt] = (f32x4){-m0, -m0, -m0, -m0};
#pragma unroll
    for (int dt = 0; dt < 4; ++dt) st.o[nt][dt] = (f32x4){0.f, 0.f, 0.f, 0.f}; }
}
__device__ __forceinline__ v4i16_t tr_read(const char* p) { return __builtin_amdgcn_ds_read_tr16_b64_v4i16((LAS v4i16_t*)(uintptr_t)(unsigned)(uintptr_t)p); }

__device__ __forceinline__ float max3f(float a, float b, float c) { float r; asm("v_max3_f32 %0, %1, %2, %3" : "=v"(r) : "v"(a), "v"(b), "v"(c)); return r; }
__device__ __forceinline__ float max2f(float a, float b) { float r; asm("v_max_f32_e32 %0, %1, %2" : "=v"(r) : "v"(a), "v"(b)); return r; }
template <int KS, int NT, int TM, int NSTEP, int ABL = 0, bool RM = false>
__device__ __forceinline__ void attn_steps(const char* img0, const char* img1, const bf16x8 (&qf)[NT][KS], AttnAcc<NT>& st, bool need_mask, const int (&lo)[NT], const int (&hi)[NT], const int (&hi2)[NT]  , int kbase, int lane) {
  f32x4 cin[2][NT];
#pragma unroll
  for (int nt = 0; nt < NT; ++nt) {
    if (RM) { const f32x4 ninf = {-INFINITY, -INFINITY, -INFINITY, -INFINITY}; cin[0][nt] = hi[nt] < 0 ? ninf : st.nsh[nt]; cin[1][nt] = hi2[nt] < 0 ? ninf : st.nsh[nt]; }
    else { cin[0][nt] = st.nsh[nt]; cin[1][nt] = st.nsh[nt]; }
  }
  asm volatile("" : "+v"(lane));
  const int fr = lane & 15, fq = lane >> 4;
  const int ksw = (fr >> 1) & 7;
  const unsigned krow = (unsigned)(fr * 128);
  const int q = fr >> 2, pp = lane & 3;
  const int vkey = 4 * fq + q;
  const int vsw = (vkey >> 1) & 3;
  bf16x8 ka[2][2][KS]; f32x4 sc[2][NT][2]; v4i16_t vl[4], vh[4];
#define AS_IMG(s_) (((s_) < 2) ? img0 : img1)
#define AS_LDK(s_) do { const char* im_ = AS_IMG(s_); _Pragma("unroll") for (int kt = 0; kt < 2; ++kt) { const unsigned ro_ = (unsigned)((32 * ((s_) & 1) + 16 * kt) * 128) + krow; \
      _Pragma("unroll") for (int kk = 0; kk < KS; ++kk) { \
        if (ABL & 8) ka[(s_) & 1][kt][kk] = qf[0][kk]; \
        else if (kk < 2) ka[(s_) & 1][kt][kk] = *(const bf16x8*)(im_ + CH_K + ro_ + (((fq + 4 * kk) ^ ksw) << 4)); \
        else ka[(s_) & 1][kt][kk] = *(const bf16x8*)(im_ + CH_R + ro_ + ((fq ^ ksw) << 4)); } } } while (0)
#define AS_LDV(s_) do { const char* im_ = AS_IMG(s_); _Pragma("unroll") for (int dt = 0; dt < 4; ++dt) { const char* vb_ = im_ + CH_V + (32 * ((s_) & 1) + vkey) * 128 + ((dt ^ vsw) << 5) + pp * 8; \
      if (ABL & 8) { vl[dt] = (v4i16_t){1, 2, 3, 4}; vh[dt] = vl[dt]; } else { vl[dt] = tr_read(vb_); vh[dt] = tr_read(vb_ + 16 * 128); } } } while (0)
#define AS_QK(s_) do { _Pragma("unroll") for (int kt = 0; kt < 2; ++kt) _Pragma("unroll") for (int kk = 0; kk < KS; ++kk) _Pragma("unroll") for (int nt = 0; nt < NT; ++nt) if (TM & (1 << nt)) \
        sc[(s_) & 1][nt][kt] = MFMA16(ka[(s_) & 1][kt][kk], qf[nt][kk], kk == 0 ? cin[(s_) >> 1][nt] : sc[(s_) & 1][nt][kt]); } while (0)
  AS_LDK(0);
  if (NSTEP > 1) AS_LDK(1);
  AS_QK(0);
#pragma unroll
  for (int s = 0; s < NSTEP; ++s) {
    const int c = s & 1;
    AS_LDV(s);
    if (s + 2 < NSTEP) AS_LDK(s + 2);
#pragma unroll
    for (int nt = 0; nt < NT; ++nt) {
      if (!(TM & (1 << nt))) continue;
      if (need_mask) {
#pragma unroll
        for (int kt = 0; kt < 2; ++kt)
#pragma unroll
          for (int r = 0; r < 4; ++r) { const int key = kbase + 32 * s + 16 * kt + 4 * fq + r; if (key < lo[nt] || key > (s < 2 ? hi[nt] : hi2[nt])) sc[c][nt][kt][r] = -INFINITY; }
      }
    }
    if (s + 1 < NSTEP) AS_QK(s + 1);
    bf16x8 pb[NT];
#pragma unroll
    for (int nt = 0; nt < NT; ++nt) {
      if (!(TM & (1 << nt))) continue;
      float p[2][4];
#pragma unroll
      for (int kt = 0; kt < 2; ++kt)
#pragma unroll
        for (int r = 0; r < 4; ++r) p[kt][r] = (ABL & 2) ? sc[c][nt][kt][r] : __builtin_amdgcn_exp2f(sc[c][nt][kt][r]);
      u32x4 w; w.x = cvtpk(p[0][0], p[0][1]); w.y = cvtpk(p[0][2], p[0][3]); w.z = cvtpk(p[1][0], p[1][1]); w.w = cvtpk(p[1][2], p[1][3]);
      pb[nt] = __builtin_bit_cast(bf16x8, w);
    }
    { const bf16x8 ones = {0x3F80, 0x3F80, 0x3F80, 0x3F80, 0x3F80, 0x3F80, 0x3F80, 0x3F80};
#pragma unroll
      for (int nt = 0; nt < NT; ++nt) if (TM & (1 << nt)) st.lv[nt] = MFMA16(ones, pb[nt], st.lv[nt]); }
#pragma unroll
    for (int dt = 0; dt < 4; ++dt) {
      const bf16x8 a = (bf16x8){vl[dt][0], vl[dt][1], vl[dt][2], vl[dt][3], vh[dt][0], vh[dt][1], vh[dt][2], vh[dt][3]};
#pragma unroll
      for (int nt = 0; nt < NT; ++nt) if (!(ABL & 1) && (TM & (1 << nt))) st.o[nt][dt] = MFMA16(a, pb[nt], st.o[nt][dt]);
      if (ABL & 1) { asm volatile("" :: "v"(a)); _Pragma("unroll") for (int nt = 0; nt < NT; ++nt) asm volatile("" :: "v"(pb[nt])); }
    }
  }
#undef AS_IMG
#undef AS_LDK
#undef AS_LDV
#undef AS_QK
}
template <int NT>
__device__ __forceinline__ void attn_probs(const char* buf, const bf16x8 (&qf)[NT][2], const float (&mfin)[NT], const float (&linv)[NT], const int (&hi)[NT], int kbase, int lane, float (&pr)[NT][4][4]) {
  const int fr = lane & 15, fq = lane >> 4; const int ksw = (fr >> 1) & 7;
#pragma unroll
  for (int kt4 = 0; kt4 < 4; ++kt4) {
    f32x4 sc[NT];
#pragma unroll
    for (int nt = 0; nt < NT; ++nt) sc[nt] = (f32x4){0.f, 0.f, 0.f, 0.f};
#pragma unroll
    for (int kk = 0; kk < 2; ++kk) {
      const bf16x8 a = *(const bf16x8*)(buf + CH_K + (16 * kt4 + fr) * 128 + (((fq + 4 * kk) ^ ksw) << 4));
#pragma unroll
      for (int nt = 0; nt < NT; ++nt) sc[nt] = MFMA16(a, qf[nt][kk], sc[nt]);
    }
#pragma unroll
    for (int nt = 0; nt < NT; ++nt)
#pragma unroll
      for (int r = 0; r < 4; ++r) { const int key = kbase + 16 * kt4 + 4 * fq + r; pr[nt][kt4][r] = (key <= hi[nt]) ? __builtin_amdgcn_exp2f(sc[nt][r] - mfin[nt]) * linv[nt] : 0.f; }
  }
}

template <int KS, int NT, bool ROPE, int ABL = 0>
__device__ __forceinline__ void attn_run(char* lds, const u16* Kg, int ldk, const u16* Vg, int ldv, const u16* Rg, int kfirst, int klast, int kmaxrow,
                                         const bf16x8 (&qf)[NT][KS], AttnAcc<NT>& st, const int (&lo)[NT], const int (&hi)[NT], int wlo, int whi, int tid, int lane) {
  ChunkRegs crA, crB;
  if (kfirst <= klast) {
    chunk_fetch<ROPE>(crA, Kg, ldk, Vg, ldv, Rg, kfirst, kmaxrow, tid);
    chunk_fetch<ROPE>(crB, Kg, ldk, Vg, ldv, Rg, kfirst + 64, kmaxrow, tid);
    int it = 0;
    for (int kb = kfirst; kb <= klast; kb += 128, it ^= 1) {
      constexpr int IMG = ROPE ? CH_BYTES_ROPE : CH_BYTES;
      char* bufA = lds + (2 * it) * IMG; char* bufB = bufA + IMG;
      chunk_store<ROPE>(crA, bufA, tid);
      chunk_store<ROPE>(crB, bufB, tid);
      __syncthreads();
      chunk_fetch<ROPE>(crA, Kg, ldk, Vg, ldv, Rg, kb + 128, kmaxrow, tid);
      chunk_fetch<ROPE>(crB, Kg, ldk, Vg, ldv, Rg, kb + 192, kmaxrow, tid);
      if (kb + 127 >= wlo && kb <= whi) {
        bool nm = false;
#pragma unroll
        for (int nt = 0; nt < NT; ++nt) nm |= (lo[nt] > kb) || (hi[nt] < kb + 127);
        nm = __any(nm);
        attn_steps<KS, NT, (1 << NT) - 1, 4, ABL>(bufA, bufB, qf, st, nm, lo, hi, hi, kb, lane);
      }
    }
  }
  __syncthreads();
}

template <int KS> __device__ __forceinline__ float qrow_norm(const bf16x8 (&q)[KS]) {
  float ss = 0.f;
#pragma unroll
  for (int kk = 0; kk < KS; ++kk)
#pragma unroll
    for (int j = 0; j < 8; ++j) { const float a = bf1((u16)q[kk][j]); ss += a * a; }
  return __builtin_sqrtf(rsum4(ss));
}
template <int NT> __device__ __forceinline__ void acc_start(AttnAcc<NT>& st, const float (&shift)[NT]) {
#pragma unroll
  for (int nt = 0; nt < NT; ++nt) { st.m[nt] = shift[nt]; st.l[nt] = 0.f; st.lv[nt] = (f32x4){0.f, 0.f, 0.f, 0.f}; st.nsh[nt] = (f32x4){-shift[nt], -shift[nt], -shift[nt], -shift[nt]};
#pragma unroll
    for (int dt = 0; dt < 4; ++dt) st.o[nt][dt] = (f32x4){0.f, 0.f, 0.f, 0.f}; }
}
__device__ __forceinline__ float wave_maxf(float v) {
#pragma unroll
  for (int o = 1; o < 64; o <<= 1) v = fmaxf(v, __shfl_xor(v, o));
  return v;
}
template <int NT> __device__ __forceinline__ void attn_finish(AttnAcc<NT>& st) {
#pragma unroll
  for (int nt = 0; nt < NT; ++nt) {
    const float lt = st.lv[nt][0] + st.l[nt];
    const float inv = lt > 0.f ? __builtin_amdgcn_rcpf(lt) : 0.f;
    st.l[nt] = lt;
#pragma unroll
    for (int dt = 0; dt < 4; ++dt) st.o[nt][dt] *= inv;
  }
}
__device__ __forceinline__ void gated_store(u16* mixrow, const f32x4 (&o)[4], int fq) {
#pragma unroll
  for (int dt = 0; dt < 4; ++dt) {
    u32x2* p = (u32x2*)(mixrow + 16 * dt + 4 * fq); const u32x2 z = *p;
    u32x2 w; w.x = cvtpk(o[dt][0] * bflo(z.x), o[dt][1] * bfhi(z.x)); w.y = cvtpk(o[dt][2] * bflo(z.y), o[dt][3] * bfhi(z.y)); *p = w;
  }
}

typedef float f32x16 __attribute__((ext_vector_type(16)));
#define MFMA32(a, b, c) __builtin_amdgcn_mfma_f32_32x32x16_bf16((a), (b), (c), 0, 0, 0)
struct Acc32 { f32x16 o[2]; f32x16 nsh; float m, lsum, lx; };
__device__ __forceinline__ void acc32_start(Acc32& st, float shift) {
  st.m = shift; st.lsum = 0.f; st.lx = 0.f;
#pragma unroll
  for (int r = 0; r < 16; ++r) { st.nsh[r] = -shift; st.o[0][r] = 0.f; st.o[1][r] = 0.f; }
}
template <int KS> __device__ __forceinline__ float qrow_norm32(const bf16x8 (&q)[KS]) {
  float ss = 0.f;
#pragma unroll
  for (int kk = 0; kk < KS; ++kk)
#pragma unroll
    for (int j = 0; j < 8; ++j) { const float a = bf1((u16)q[kk][j]); ss += a * a; }
  auto b = __builtin_amdgcn_permlane32_swap(__float_as_uint(ss), __float_as_uint(ss), false, false);
  return __builtin_sqrtf(__uint_as_float(b[0]) + __uint_as_float(b[1]));
}
template <int KS, int NSTEP, int ABL = 0>
__device__ __forceinline__ void attn_steps32(const char* img0, const char* img1, const bf16x8 (&qf)[KS], Acc32& st, bool need_mask, int lo, int hi, int kbase, int lane) {
  asm volatile("" : "+v"(lane));
  const int l31 = lane & 31, hh = lane >> 5;
  const int ksw = (l31 >> 1) & 7;
  const unsigned krow = (unsigned)(l31 * 128);
  const int q = (lane & 15) >> 2, pp = lane & 3, g16 = (lane >> 4) & 1;
  const int vrow = 4 * hh + q;
  const int vsw = ((q >> 1) & 1) << 1;
  bf16x8 ka[2][KS]; f32x16 sc[2]; v4i16_t vf[2][2][2];
#define A3_IMG(s_) (((s_) < 2) ? img0 : img1)
#define A3_LDK(s_) do { const char* im_ = A3_IMG(s_); const unsigned ro_ = (unsigned)(32 * ((s_) & 1) * 128) + krow; \
      _Pragma("unroll") for (int kk = 0; kk < KS; ++kk) { \
        if (ABL & 8) ka[(s_) & 1][kk] = qf[kk]; \
        else if (kk < 4) ka[(s_) & 1][kk] = *(const bf16x8*)(im_ + CH_K + ro_ + (((hh + 2 * kk) ^ ksw) << 4)); \
        else ka[(s_) & 1][kk] = *(const bf16x8*)(im_ + CH_R + ro_ + (((hh + 2 * (kk - 4)) ^ ksw) << 4)); } } while (0)
#define A3_LDV(s_) do { const char* im_ = A3_IMG(s_); _Pragma("unroll") for (int ks = 0; ks < 2; ++ks) _Pragma("unroll") for (int db = 0; db < 2; ++db) { \
      const char* vb_ = im_ + CH_V + (32 * ((s_) & 1) + 16 * ks + vrow) * 128 + (((2 * db + g16) ^ vsw) << 5) + pp * 8; \
      if (ABL & 8) { vf[ks][db][0] = (v4i16_t){1, 2, 3, 4}; vf[ks][db][1] = vf[ks][db][0]; } else { vf[ks][db][0] = tr_read(vb_); vf[ks][db][1] = tr_read(vb_ + 8 * 128); } } } while (0)
#define A3_QK(s_) do { _Pragma("unroll") for (int kk = 0; kk < KS; ++kk) sc[(s_) & 1] = MFMA32(ka[(s_) & 1][kk], qf[kk], kk == 0 ? st.nsh : sc[(s_) & 1]); } while (0)
  A3_LDK(0);
  if (NSTEP > 1) A3_LDK(1);
  A3_QK(0);
#pragma unroll
  for (int s = 0; s < NSTEP; ++s) {
    const int c = s & 1;
    A3_LDV(s);
    if (s + 2 < NSTEP) A3_LDK(s + 2);
    if (need_mask) {
#pragma unroll
      for (int r = 0; r < 16; ++r) { const int key = kbase + 32 * s + (r & 3) + 8 * (r >> 2) + 4 * hh; if (key < lo || key > hi) sc[c][r] = -INFINITY; }
    }
    if (s + 1 < NSTEP) A3_QK(s + 1);
    float p[16]; float ps = 0.f;
#pragma unroll
    for (int r = 0; r < 16; ++r) { p[r] = (ABL & 2) ? sc[c][r] : __builtin_amdgcn_exp2f(sc[c][r]); ps += p[r]; }
    st.lsum += ps;
#pragma unroll
    for (int ks = 0; ks < 2; ++ks) {
      u32x4 w; w.x = cvtpk(p[8 * ks], p[8 * ks + 1]); w.y = cvtpk(p[8 * ks + 2], p[8 * ks + 3]); w.z = cvtpk(p[8 * ks + 4], p[8 * ks + 5]); w.w = cvtpk(p[8 * ks + 6], p[8 * ks + 7]);
      const bf16x8 pb = __builtin_bit_cast(bf16x8, w);
#pragma unroll
      for (int db = 0; db < 2; ++db) {
        const bf16x8 a = (bf16x8){vf[ks][db][0][0], vf[ks][db][0][1], vf[ks][db][0][2], vf[ks][db][0][3], vf[ks][db][1][0], vf[ks][db][1][1], vf[ks][db][1][2], vf[ks][db][1][3]};
        if (!(ABL & 1)) st.o[db] = MFMA32(a, pb, st.o[db]); else { asm volatile("" :: "v"(a)); asm volatile("" :: "v"(pb)); }
      }
    }
  }
#undef A3_IMG
#undef A3_LDK
#undef A3_LDV
#undef A3_QK
}
template <int KS, bool ROPE, int ABL = 0>
__device__ __forceinline__ void attn_run32(char* lds, const u16* Kg, int ldk, const u16* Vg, int ldv, const u16* Rg, int kfirst, int klast, int kmaxrow,
                                           const bf16x8 (&qf)[KS], Acc32& st, int lo, int hi, int wlo, int whi, int tid, int lane) {
  ChunkRegs crA, crB;
  if (kfirst <= klast) {
    chunk_fetch<ROPE>(crA, Kg, ldk, Vg, ldv, Rg, kfirst, kmaxrow, tid);
    chunk_fetch<ROPE>(crB, Kg, ldk, Vg, ldv, Rg, kfirst + 64, kmaxrow, tid);
    int it = 0;
    for (int kb = kfirst; kb <= klast; kb += 128, it ^= 1) {
      constexpr int IMG = ROPE ? CH_BYTES_ROPE : CH_BYTES;
      char* bufA = lds + (2 * it) * IMG; char* bufB = bufA + IMG;
      chunk_store<ROPE, true>(crA, bufA, tid);
      chunk_store<ROPE, true>(crB, bufB, tid);
      __syncthreads();
      chunk_fetch<ROPE>(crA, Kg, ldk, Vg, ldv, Rg, kb + 128, kmaxrow, tid);
      chunk_fetch<ROPE>(crB, Kg, ldk, Vg, ldv, Rg, kb + 192, kmaxrow, tid);
      if (kb + 127 >= wlo && kb <= whi) {
        const bool nm = __any((lo > kb) || (hi < kb + 127));
        attn_steps32<KS, 4, ABL>(bufA, bufB, qf, st, nm, lo, hi, kb, lane);
      }
    }
  }
  __syncthreads();
}
struct Acc32x2 { f32x16 o[2][2]; float m[2], lsum[2]; };
template <int KS, int NSTEP>
__device__ __forceinline__ void attn_steps32x2(const char* img0, const char* img1, const bf16x8 (&qf)[2][KS], Acc32x2& st, bool need_mask, const int (&hi)[2], int kbase, int lane) {
  asm volatile("" : "+v"(lane));
  const int l31 = lane & 31, hh = lane >> 5;
  const int ksw = (l31 >> 1) & 7;
  const unsigned krow = (unsigned)(l31 * 128);
  const int q = (lane & 15) >> 2, pp = lane & 3, g16 = (lane >> 4) & 1;
  const int vrow = 4 * hh + q;
  const int vsw = ((q >> 1) & 1) << 1;
  const f32x16 Z = {0.f, 0.f, 0.f, 0.f, 0.f, 0.f, 0.f, 0.f, 0.f, 0.f, 0.f, 0.f, 0.f, 0.f, 0.f, 0.f};
#pragma unroll 1
  for (int s = 0; s < NSTEP; ++s) {
    const char* im = (s < 2) ? img0 : img1;
    bf16x8 ka[KS]; v4i16_t vf[2][2][2];
    { const unsigned ro = (unsigned)(32 * (s & 1) * 128) + krow;
#pragma unroll
      for (int kk = 0; kk < KS; ++kk) {
        if (kk < 4) ka[kk] = *(const bf16x8*)(im + CH_K + ro + (((hh + 2 * kk) ^ ksw) << 4));
        else ka[kk] = *(const bf16x8*)(im + CH_R + ro + (((hh + 2 * (kk - 4)) ^ ksw) << 4));
      } }
#pragma unroll
    for (int ks = 0; ks < 2; ++ks)
#pragma unroll
      for (int db = 0; db < 2; ++db) {
        const char* vb = im + CH_V + (32 * (s & 1) + 16 * ks + vrow) * 128 + (((2 * db + g16) ^ vsw) << 5) + pp * 8;
        vf[ks][db][0] = tr_read(vb); vf[ks][db][1] = tr_read(vb + 8 * 128);
      }
    __builtin_amdgcn_sched_barrier(0);
    f32x16 sc[2];
#pragma unroll
    for (int kk = 0; kk < KS; ++kk)
#pragma unroll
      for (int t = 0; t < 2; ++t) sc[t] = MFMA32(ka[kk], qf[t][kk], kk == 0 ? Z : sc[t]);
    bf16x8 pb[2][2];
#pragma unroll
    for (int t = 0; t < 2; ++t) {
      if (need_mask) {
#pragma unroll
        for (int r = 0; r < 16; ++r) { const int key = kbase + 32 * s + (r & 3) + 8 * (r >> 2) + 4 * hh; if (key > hi[t]) sc[t][r] = -INFINITY; }
      }
      float p[16]; float ps = 0.f;
#pragma unroll
      for (int r = 0; r < 16; ++r) { p[r] = __builtin_amdgcn_exp2f(sc[t][r] - st.m[t]); ps += p[r]; }
      st.lsum[t] += ps;
#pragma unroll
      for (int ks = 0; ks < 2; ++ks) { u32x4 w; w.x = cvtpk(p[8 * ks], p[8 * ks + 1]); w.y = cvtpk(p[8 * ks + 2], p[8 * ks + 3]); w.z = cvtpk(p[8 * ks + 4], p[8 * ks + 5]); w.w = cvtpk(p[8 * ks + 6], p[8 * ks + 7]); pb[t][ks] = __builtin_bit_cast(bf16x8, w); }
    }
#pragma unroll
    for (int ks = 0; ks < 2; ++ks)
#pragma unroll
      for (int db = 0; db < 2; ++db) {
        const bf16x8 a = (bf16x8){vf[ks][db][0][0], vf[ks][db][0][1], vf[ks][db][0][2], vf[ks][db][0][3], vf[ks][db][1][0], vf[ks][db][1][1], vf[ks][db][1][2], vf[ks][db][1][3]};
#pragma unroll
        for (int t = 0; t < 2; ++t) st.o[t][db] = MFMA32(a, pb[t][ks], st.o[t][db]);
      }
  }
}
__device__ __forceinline__ float attn_finish32(Acc32& st) {
  auto b = __builtin_amdgcn_permlane32_swap(__float_as_uint(st.lsum), __float_as_uint(st.lsum), false, false);
  const float lt = __uint_as_float(b[0]) + __uint_as_float(b[1]) + st.lx;
  const float inv = lt > 0.f ? __builtin_amdgcn_rcpf(lt) : 0.f;
#pragma unroll
  for (int r = 0; r < 16; ++r) { st.o[0][r] *= inv; st.o[1][r] *= inv; }
  return lt;
}
__device__ __forceinline__ void gated_store32(u16* mixrow, const f32x16 (&o)[2], int hh) {
#pragma unroll
  for (int db = 0; db < 2; ++db)
#pragma unroll
    for (int rg = 0; rg < 4; ++rg) {
      u32x2* p = (u32x2*)(mixrow + 32 * db + 8 * rg + 4 * hh); const u32x2 z = *p;
      u32x2 w; w.x = cvtpk(o[db][4 * rg] * bflo(z.x), o[db][4 * rg + 1] * bfhi(z.x)); w.y = cvtpk(o[db][4 * rg + 2] * bflo(z.y), o[db][4 * rg + 3] * bfhi(z.y)); *p = w;
    }
}
__device__ __forceinline__ int vblock() { return (gridDim.x & 7) == 0 ? (int)((blockIdx.x & 7) * (gridDim.x >> 3) + (blockIdx.x >> 3)) : (int)blockIdx.x; }

__device__ __forceinline__ void swa_unit(char* lds, const Params& p, int b, int kvh, int tile) {
  const int tid = threadIdx.x, lane = tid & 63, wid = __builtin_amdgcn_readfirstlane(tid >> 6), l31 = lane & 31, hh = lane >> 5;
  unsigned char* ws = p.ws;
  const u16* kv = (const u16*)(ws + L0_KVB) + (size_t)b * SEQ * 256;
  const int q0 = tile * 64, qw = q0 + wid * 8;
  const int qpos = qw + (l31 >> 2), head = kvh * 4 + (l31 & 3);
  const float kbound = 8.08f * wave_maxf(fabsf(p.in[I_B_QKN][64 + lane]));
  bf16x8 qf[4];
  { const u16* qr = (const u16*)(ws + L0_QB) + ((size_t)(b * SEQ + qpos)) * 512 + head * 64 + 8 * hh;
#pragma unroll
    for (int kk = 0; kk < 4; ++kk) qf[kk] = *(const bf16x8*)(qr + 16 * kk); }
  const float sink = p.in[I_B_SINKS][head] * LOG2E;
  const float shift = fmaxf(qrow_norm32<4>(qf) * kbound, sink);
  Acc32 st; acc32_start(st, shift);
  st.lx = __builtin_amdgcn_exp2f(sink - shift);
  const int kfirst = q0 >= 128 ? q0 - 128 : 0, klast = q0 + 63;
  attn_run32<4, false>(lds, kv + kvh * 64, 256, kv + 128 + kvh * 64, 256, nullptr, kfirst, klast, SEQ - 1, qf, st, qpos - 127, qpos, qw - 127, qw + 7, tid, lane);
  attn_finish32(st);
  gated_store32((u16*)(ws + WS_MIX) + ((size_t)(b * SEQ + qpos)) * 1024 + 512 + head * 64, st.o, hh);
}

template <int ABL = 0>
__device__ __forceinline__ void mla_unit(char* lds, const Params& p, int b, int h, int qb  , u16* outbuf) {
  const int tid = threadIdx.x, lane = tid & 63, wid = __builtin_amdgcn_readfirstlane(tid >> 6), l31 = lane & 31, hh = lane >> 5;
  unsigned char* ws = p.ws;
  const size_t tb = (size_t)b * SEQ;
  const int q0 = qb * 512, qw = q0 + wid * 64;
  const float gn = wave_maxf(fabsf(p.in[I_D_NOPEN][64 + lane])), gr = wave_maxf(fabsf(p.in[I_D_ROPEN][32 + (lane & 31)]));
  const float kbound = 1.01f * __builtin_sqrtf(64.f * gn * gn + 32.f * gr * gr);
  bf16x8 qf[2][6]; int hi[2];
  Acc32x2 st;
#pragma unroll
  for (int t = 0; t < 2; ++t) {
    const int qpos = qw + 32 * t + l31;
    const u16* qr = (const u16*)(ws + L1_QM) + (tb + qpos) * 768 + h * 96 + 8 * hh;
#pragma unroll
    for (int kk = 0; kk < 6; ++kk) qf[t][kk] = *(const bf16x8*)(qr + 16 * kk);
    hi[t] = qpos; st.m[t] = qrow_norm32<6>(qf[t]) * kbound; st.lsum[t] = 0.f;
#pragma unroll
    for (int r = 0; r < 16; ++r) { st.o[t][0][r] = 0.f; st.o[t][1][r] = 0.f; }
  }
  const u16* Kg = (const u16*)(ws + L1_KN) + tb * 512 + h * 64; const u16* Vg = (const u16*)(ws + L1_VM) + tb * 512 + h * 64; const u16* Rg = (const u16*)(ws + L1_KROPE) + tb * 32;
  const int klast = q0 + 511, whi = qw + 63;
  ChunkRegs crA, crB;
  chunk_fetch<true>(crA, Kg, 512, Vg, 512, Rg, 0, SEQ - 1, tid);
  chunk_fetch<true>(crB, Kg, 512, Vg, 512, Rg, 64, SEQ - 1, tid);
  int it = 0;
  for (int kb = 0; kb <= klast; kb += 128, it ^= 1) {
    char* bufA = lds + (2 * it) * CH_BYTES_ROPE; char* bufB = bufA + CH_BYTES_ROPE;
    chunk_store<true, true>(crA, bufA, tid);
    chunk_store<true, true>(crB, bufB, tid);
    __syncthreads();
    chunk_fetch<true>(crA, Kg, 512, Vg, 512, Rg, kb + 128, SEQ - 1, tid);
    chunk_fetch<true>(crB, Kg, 512, Vg, 512, Rg, kb + 192, SEQ - 1, tid);
    if (kb <= whi) {
      const bool nm = kb + 127 > qw;
      attn_steps32x2<6, 4>(bufA, bufB, qf, st, nm, hi, kb, lane);
    }
  }
  __syncthreads();
#pragma unroll
  for (int t = 0; t < 2; ++t) {
    auto bsw = __builtin_amdgcn_permlane32_swap(__float_as_uint(st.lsum[t]), __float_as_uint(st.lsum[t]), false, false);
    const float lt = __uint_as_float(bsw[0]) + __uint_as_float(bsw[1]);
    const float inv = lt > 0.f ? __builtin_amdgcn_rcpf(lt) : 0.f;
#pragma unroll
    for (int r = 0; r < 16; ++r) { st.o[t][0][r] *= inv; st.o[t][1][r] *= inv; }
    gated_store32(outbuf + (tb + qw + 32 * t + l31) * 1024 + 512 + h * 64, st.o[t], hh);
  }
}
constexpr int NSA_IMP = 2 * CH_BYTES;
constexpr int NSA_SEL = 4 * CH_BYTES;
constexpr int NSA_RES = NSA_SEL + 1024;
constexpr int NSA_LDS = NSA_RES + 65536;

__device__ __forceinline__ unsigned wave_max_u32(unsigned v) {
  v = max(v, (unsigned)__builtin_amdgcn_update_dpp(0, (int)v, 0xB1, 0xF, 0xF, true));
  v = max(v, (unsigned)__builtin_amdgcn_update_dpp(0, (int)v, 0x4E, 0xF, 0xF, true));
  v = max(v, (unsigned)__builtin_amdgcn_update_dpp(0, (int)v, 0x141, 0xF, 0xF, true));
  v = max(v, (unsigned)__builtin_amdgcn_update_dpp(0, (int)v, 0x140, 0xF, 0xF, true));
  const unsigned a = __builtin_amdgcn_readlane(v, 0), b = __builtin_amdgcn_readlane(v, 16), c = __builtin_amdgcn_readlane(v, 32), d = __builtin_amdgcn_readlane(v, 48);
  return max(max(a, b), max(c, d));
}
__device__ __forceinline__ float quad_sum(float v) {
  v += __int_as_float(__builtin_amdgcn_update_dpp(0, __float_as_int(v), 0xB1, 0xF, 0xF, true));
  v += __int_as_float(__builtin_amdgcn_update_dpp(0, __float_as_int(v), 0x4E, 0xF, 0xF, true));
  return v;
}
__device__ __forceinline__ float wave_max(float v) {
#pragma unroll
  for (int o = 1; o < 64; o <<= 1) v = fmaxf(v, __shfl_xor(v, o));
  return v;
}

template <int ABL = 0>
__device__ __forceinline__ void nsa_unit(char* lds, const Params& p, int b, int kvh, int tile, u16* outbuf) {
  const int tid = threadIdx.x, lane = tid & 63, wid = __builtin_amdgcn_readfirstlane(tid >> 6), fr = lane & 15, fq = lane >> 4;
  unsigned char* ws = p.ws;
  const size_t tb = (size_t)b * SEQ;
  const int q0 = tile * 64, qw = q0 + wid * 8;
  float* imp = (float*)(lds + NSA_IMP) + wid * 1024;
  unsigned* selw = (unsigned*)(lds + NSA_SEL) + wid * 32;
  bf16x8 qf[2][2]; int qpos[2], lo[2], hi[2];
#pragma unroll
  for (int nt = 0; nt < 2; ++nt) {
    qpos[nt] = qw + 4 * nt + (fr >> 2);
    const u16* qr = (const u16*)(ws + L1_QC) + (tb + qpos[nt]) * 512 + (kvh * 4 + (fr & 3)) * 64 + 8 * fq;
    qf[nt][0] = *(const bf16x8*)qr; qf[nt][1] = *(const bf16x8*)(qr + 32);
  }
  f32x4* resb = (f32x4*)(lds + NSA_RES) + wid * 512 + lane;
  float qn[2];
#pragma unroll
  for (int nt = 0; nt < 2; ++nt) qn[nt] = qrow_norm<2>(qf[nt]);
  const float gk0 = 8.08f * wave_maxf(fabsf(p.in[I_C_KN][lane])), gk1 = 8.08f * wave_maxf(fabsf(p.in[I_C_KN][64 + lane])), gk2 = 8.08f * wave_maxf(fabsf(p.in[I_C_KN][128 + lane]));
  const float* gates = (const float*)(ws + L1_GATES);
  const u16* kc = (const u16*)(ws + L1_KCMP) + ((size_t)b * 512 * 2 + kvh) * 64; const u16* vc = (const u16*)(ws + L1_VCMP) + ((size_t)b * 512 * 2 + kvh) * 64;
  const int nlast = (q0 + 63 - 31) >> 4;
  float mfin[2], linv[2];
  {
    AttnAcc<2> st; { const float sh[2] = {qn[0] * gk0, qn[1] * gk0}; acc_start<2>(st, sh); }
#pragma unroll
    for (int nt = 0; nt < 2; ++nt) { lo[nt] = 0; hi[nt] = qpos[nt] >= 31 ? ((qpos[nt] - 31) >> 4) : -1; }
    const int whi = (qw + 7 >= 31) ? ((qw + 7 - 31) >> 4) : -1;
    attn_run<2, 2, false>(lds, kc, 128, vc, 128, nullptr, 0, nlast, 510, qf, st, lo, hi, 0, whi, tid, lane);
    attn_finish<2>(st);
#pragma unroll
    for (int nt = 0; nt < 2; ++nt) {
      mfin[nt] = st.m[nt]; linv[nt] = st.l[nt] > 0.f ? __builtin_amdgcn_rcpf(st.l[nt]) : 0.f;
      const float g = gates[(tb + qpos[nt]) * 24 + (kvh * 4 + (fr & 3)) * 3 + 0];
#pragma unroll
      for (int dt = 0; dt < 4; ++dt) resb[(nt * 4 + dt) * 64] = st.o[nt][dt] * g;
    }
    if (!(ABL & 8)) {
#pragma unroll
    for (int i = 0; i < 4; ++i) *(f32x4*)(imp + (i * 64 + lane) * 4) = (f32x4){0.f, 0.f, 0.f, 0.f};
    ChunkRegs cr; chunk_fetch<false>(cr, kc, 128, vc, 128, nullptr, 0, 510, tid);
    int it = 0;
    for (int kb = 0; kb <= nlast; kb += 64, ++it) {
      char* buf = lds + (it & 1) * CH_BYTES;
      chunk_store<false>(cr, buf, tid);
      __syncthreads();
      if (kb + 64 <= nlast) chunk_fetch<false>(cr, kc, 128, vc, 128, nullptr, kb + 64, 510, tid);
      if (kb <= whi) {
        const int ksw = (fr >> 1) & 7;
#pragma unroll
        for (int kt4 = 0; kt4 < 4; ++kt4) {
          f32x4 sc2[2] = {(f32x4){0.f, 0.f, 0.f, 0.f}, (f32x4){0.f, 0.f, 0.f, 0.f}};
#pragma unroll
          for (int kk = 0; kk < 2; ++kk) {
            const bf16x8 a = *(const bf16x8*)(buf + CH_K + (16 * kt4 + fr) * 128 + (((fq + 4 * kk) ^ ksw) << 4));
#pragma unroll
            for (int nt = 0; nt < 2; ++nt) sc2[nt] = MFMA16(a, qf[nt][kk], sc2[nt]);
          }
#pragma unroll
          for (int nt = 0; nt < 2; ++nt) {
            float pr[4];
#pragma unroll
            for (int r = 0; r < 4; ++r) { const int key = kb + 16 * kt4 + 4 * fq + r; pr[r] = (key <= hi[nt]) ? __builtin_amdgcn_exp2f(sc2[nt][r] - mfin[nt]) * linv[nt] : 0.f; }
            float A = 2.f * (pr[0] + pr[1] + pr[2]) + pr[3], B = pr[3];
            A = quad_sum(A); B = quad_sum(B);
            if ((fr & 3) == 0) {
              const int jb = (kb >> 2) + 4 * kt4 + fq; float* row = imp + (4 * nt + (fr >> 2)) * 128;
              atomicAdd(row + jb, A);
              if (jb + 1 < 128) atomicAdd(row + jb + 1, B);
            }
          }
        }
      }
    }
    __syncthreads();
    }
  }
  if (!(ABL & 1)) {
    unsigned char* selb = (unsigned char*)selw;
    int lane_s = lane; asm volatile("" : "+v"(lane_s));
#pragma unroll 1
    for (int half = 0; half < 2; ++half) {
      const int qq = 4 * half + (lane_s >> 4), l16 = lane_s & 15;
      const int t = qw + qq, cur = t >> 6;
      const f32x4 i0 = *(const f32x4*)(imp + qq * 128 + 8 * l16), i1 = *(const f32x4*)(imp + qq * 128 + 8 * l16 + 4);
      const float iv[8] = {i0.x, i0.y, i0.z, i0.w, i1.x, i1.y, i1.z, i1.w};
      unsigned key[8]; unsigned flags = 0u;
#pragma unroll
      for (int i = 0; i < 8; ++i) {
        const int j = 8 * l16 + i;
        const bool small = cur + 1 <= 16;
        if (small ? (j <= cur) : (j == 0 || j == cur || j == cur - 1)) flags |= 1u << i;
        key[i] = (!small && j >= 1 && j <= cur - 2) ? ((__float_as_uint(iv[i]) & ~127u) | (unsigned)(127 - j)) : 0u;
      }
      for (int rnd = 0; rnd < 13; ++rnd) {
        unsigned m = max(max(max(key[0], key[1]), max(key[2], key[3])), max(max(key[4], key[5]), max(key[6], key[7])));
        m = max(m, (unsigned)__builtin_amdgcn_update_dpp(0, (int)m, 0xB1, 0xF, 0xF, true));
        m = max(m, (unsigned)__builtin_amdgcn_update_dpp(0, (int)m, 0x4E, 0xF, 0xF, true));
        m = max(m, (unsigned)__builtin_amdgcn_update_dpp(0, (int)m, 0x141, 0xF, 0xF, true));
        m = max(m, (unsigned)__builtin_amdgcn_update_dpp(0, (int)m, 0x140, 0xF, 0xF, true));
#pragma unroll
        for (int i = 0; i < 8; ++i) if (m != 0u && key[i] == m) { key[i] = 0u; flags |= 1u << i; }
      }
      selb[qq * 16 + l16] = (unsigned char)flags;
    }
  }
  __builtin_amdgcn_wave_barrier();
  if (!(ABL & 2))
  {
    AttnAcc<2> st; { const float sh[2] = {qn[0] * gk1, qn[1] * gk1}; acc_start<2>(st, sh); }
    const u16* kg = (const u16*)(ws + L1_KVS) + tb * 256 + kvh * 64; const u16* vg = kg + 128;
    ChunkRegs crA, crB; chunk_fetch<false>(crA, kg, 256, vg, 256, nullptr, 0, SEQ - 1, tid);
    chunk_fetch<false>(crB, kg, 256, vg, 256, nullptr, 64, SEQ - 1, tid);
    int it = 0;
    for (int j2 = 0; j2 <= tile; j2 += 2, it ^= 1) {
      char* bufA = lds + (2 * it) * CH_BYTES; char* bufB = bufA + CH_BYTES;
      chunk_store<false>(crA, bufA, tid);
      chunk_store<false>(crB, bufB, tid);
      __syncthreads();
      chunk_fetch<false>(crA, kg, 256, vg, 256, nullptr, (j2 + 2) * 64, SEQ - 1, tid);
      chunk_fetch<false>(crB, kg, 256, vg, 256, nullptr, (j2 + 3) * 64, SEQ - 1, tid);
      unsigned tmA = 0, tmB = 0; int hiA[2], hiB[2];
#pragma unroll
      for (int nt = 0; nt < 2; ++nt) {
        const unsigned word = selw[(4 * nt + (fr >> 2)) * 4 + (j2 >> 5)];
        const bool sA = (word >> (j2 & 31)) & 1u, sB = ((word >> ((j2 & 31) + 1)) & 1u) && (j2 + 1 <= tile);
        lo[nt] = 0; hiA[nt] = sA ? qpos[nt] : -1; hiB[nt] = sB ? qpos[nt] : -1;
        if (__any(sA)) tmA |= 1u << nt;
        if (__any(sB)) tmB |= 1u << nt;
      }
      const bool dg = 64 * j2 + 127 > qw;
      if (tmA == 3u && tmB == 3u) attn_steps<2, 2, 3, 4, 0, true>(bufA, bufB, qf, st, dg, lo, hiA, hiB, 64 * j2, lane);
      else {
        if (tmA == 3u) attn_steps<2, 2, 3, 2, 0, true>(bufA, bufA, qf, st, dg, lo, hiA, hiA, 64 * j2, lane);
        else if (tmA == 1u) attn_steps<2, 2, 1, 2, 0, true>(bufA, bufA, qf, st, dg, lo, hiA, hiA, 64 * j2, lane);
        else if (tmA == 2u) attn_steps<2, 2, 2, 2, 0, true>(bufA, bufA, qf, st, dg, lo, hiA, hiA, 64 * j2, lane);
        if (tmB == 3u) attn_steps<2, 2, 3, 2, 0, true>(bufB, bufB, qf, st, dg, lo, hiB, hiB, 64 * j2 + 64, lane);
        else if (tmB == 1u) attn_steps<2, 2, 1, 2, 0, true>(bufB, bufB, qf, st, dg, lo, hiB, hiB, 64 * j2 + 64, lane);
        else if (tmB == 2u) attn_steps<2, 2, 2, 2, 0, true>(bufB, bufB, qf, st, dg, lo, hiB, hiB, 64 * j2 + 64, lane);
      }
    }
    __syncthreads();
    attn_finish<2>(st);
#pragma unroll
    for (int nt = 0; nt < 2; ++nt) {
      const float g = gates[(tb + qpos[nt]) * 24 + (kvh * 4 + (fr & 3)) * 3 + 1];
#pragma unroll
      for (int dt = 0; dt < 4; ++dt) resb[(nt * 4 + dt) * 64] += st.o[nt][dt] * g;
    }
  }
  if (!(ABL & 4))
  {
    AttnAcc<2> st; { const float sh[2] = {qn[0] * gk2, qn[1] * gk2}; acc_start<2>(st, sh); }
#pragma unroll
    for (int nt = 0; nt < 2; ++nt) { lo[nt] = qpos[nt] - 511; hi[nt] = qpos[nt]; }
    const u16* kg = (const u16*)(ws + L1_KVW) + tb * 256 + kvh * 64;
    attn_run<2, 2, false>(lds, kg, 256, kg + 128, 256, nullptr, q0 >= 512 ? q0 - 512 : 0, q0 + 63, SEQ - 1, qf, st, lo, hi, qw - 511, qw + 7, tid, lane);
    attn_finish<2>(st);
#pragma unroll
    for (int nt = 0; nt < 2; ++nt) {
      const float g = gates[(tb + qpos[nt]) * 24 + (kvh * 4 + (fr & 3)) * 3 + 2];
#pragma unroll
      for (int dt = 0; dt < 4; ++dt) resb[(nt * 4 + dt) * 64] += st.o[nt][dt] * g;
    }
  }
#pragma unroll
  for (int nt = 0; nt < 2; ++nt) { f32x4 res[4];
#pragma unroll
    for (int dt = 0; dt < 4; ++dt) res[dt] = resb[(nt * 4 + dt) * 64];
    gated_store(outbuf + (tb + qpos[nt]) * 1024 + (kvh * 4 + (fr & 3)) * 64, res, fq); }
}

__device__ __forceinline__ void cmp_unit(char* lds, const Params& p, int which, int mblk) {
  const int tid = threadIdx.x, lane = tid & 63, wid = __builtin_amdgcn_readfirstlane(tid >> 6), fr = lane & 15, fq = lane >> 4;
  unsigned char* ws = p.ws;
  const u16* src = (const u16*)(ws + (which == 0 ? L1_KCR : L1_VCR));
  const u16* w1t = (const u16*)(ws + WS_WC1T) + (size_t)which * 128 * 2048;
  const u16* w2t = (const u16*)(ws + WS_WC2T) + (size_t)which * 64 * 128;
  const float* cb = (const float*)(ws + WS_CBIAS) + which * 128;
  u16* H = (u16*)lds;
  float* O = (float*)(lds + 16384);
  float* RS = (float*)(lds + 32768);
  const int m0 = mblk * 32;
  const u16* arow[2];
#pragma unroll
  for (int mt = 0; mt < 2; ++mt) { int m = m0 + 16 * mt + fr; if (m > 4087) m = 4087; const int bn = m >> 1, kv = m & 1, bb = bn / 511, n = bn % 511; arow[mt] = src + ((size_t)(bb * SEQ + 16 * n)) * 128 + kv * 64 + 8 * fq; }
  const u16* brow = w1t + (size_t)(16 * wid + fr) * 2048 + 8 * fq;
  f32x4 acc[2] = {(f32x4){0.f, 0.f, 0.f, 0.f}, (f32x4){0.f, 0.f, 0.f, 0.f}};
#pragma unroll 4
  for (int ks = 0; ks < 64; ++ks) {
    const int aoff = (ks >> 1) * 128 + (ks & 1) * 32;
    const bf16x8 a0 = *(const bf16x8*)(arow[0] + aoff), a1 = *(const bf16x8*)(arow[1] + aoff), bb = *(const bf16x8*)(brow + ks * 32);
    acc[0] = MFMA16(bb, a0, acc[0]); acc[1] = MFMA16(bb, a1, acc[1]);
  }
  {
    const f32x4 bias = *(const f32x4*)(cb + 16 * wid + 4 * fq);
#pragma unroll
    for (int mt = 0; mt < 2; ++mt) {
      u32x2 w; w.x = cvtpk(silu_f(acc[mt][0] + bias[0]), silu_f(acc[mt][1] + bias[1])); w.y = cvtpk(silu_f(acc[mt][2] + bias[2]), silu_f(acc[mt][3] + bias[3]));
      *(u32x2*)(H + (16 * mt + fr) * 136 + 16 * wid + 4 * fq) = w;
    }
  }
  __syncthreads();
  if (wid < 4) {
    f32x4 a2[2] = {(f32x4){0.f, 0.f, 0.f, 0.f}, (f32x4){0.f, 0.f, 0.f, 0.f}};
#pragma unroll
    for (int ks = 0; ks < 4; ++ks) {
      const bf16x8 bb = *(const bf16x8*)(w2t + (size_t)(16 * wid + fr) * 128 + 32 * ks + 8 * fq);
#pragma unroll
      for (int mt = 0; mt < 2; ++mt) { const bf16x8 a = *(const bf16x8*)(H + (16 * mt + fr) * 136 + 32 * ks + 8 * fq); a2[mt] = MFMA16(bb, a, a2[mt]); }
    }
#pragma unroll
    for (int mt = 0; mt < 2; ++mt)
#pragma unroll
      for (int r = 0; r < 4; ++r) O[(16 * mt + fr) * 65 + 16 * wid + 4 * fq + r] = a2[mt][r];
  }
  __syncthreads();
  if (which == 0 && tid < 32) { float ss = 0.f; for (int c = 0; c < 64; ++c) { const float v = O[tid * 65 + c]; ss += v * v; } RS[tid] = __builtin_amdgcn_rsqf(ss * (1.f / 64.f) + EPS); }
  __syncthreads();
  {
    const f32x2* rope64 = (const f32x2*)(ws + WS_ROPE64); const float* gk = p.in[I_C_KN];
    u16* dstb = (u16*)(ws + (which == 0 ? L1_KCMP : L1_VCMP));
#pragma unroll
    for (int e = 0; e < 2; ++e) {
      const int item = tid + 512 * e, row = item >> 5, i = item & 31, m = m0 + row;
      if (m <= 4087) {
        const int bn = m >> 1, kv = m & 1, bb = bn / 511, n = bn % 511;
        float a = O[row * 65 + i], c = O[row * 65 + i + 32];
        if (which == 0) {
          const float rs = RS[row]; a *= rs * gk[i]; c *= rs * gk[i + 32];
          const f32x2 cs = rope64[(16 * n + 31) * 32 + i];
          const float a2 = a * cs.x - c * cs.y, c2 = c * cs.x + a * cs.y; a = a2; c = c2;
        }
        u16* d = dstb + ((size_t)(bb * 512 + n) * 2 + kv) * 64;
        d[i] = (u16)(cvtpk(a, 0.f) & 0xffffu); d[i + 32] = (u16)(cvtpk(c, 0.f) & 0xffffu);
      }
    }
  }
  __syncthreads();
}
typedef float f32x16 __attribute__((ext_vector_type(16)));
#define MFMA32(a, b, c) __builtin_amdgcn_mfma_f32_32x32x16_bf16((a), (b), (c), 0, 0, 0)
constexpr int DSA_KI = 131072;
constexpr int DSA_LDS = DSA_KI + 16384;

template <int NB>
__device__ __forceinline__ void find_bin(const unsigned* hist, int need, int lane, int& bin, int& above) {
  constexpr int PER = NB / 64, W = PER / 2;
  int cnt[PER];
#pragma unroll
  for (int i = 0; i < W / 4; ++i) { const u32x4 v = *(const u32x4*)(hist + lane * W + 4 * i);
#pragma unroll
    for (int k = 0; k < 4; ++k) { cnt[8 * i + 2 * k] = (int)(v[k] & 0xffffu); cnt[8 * i + 2 * k + 1] = (int)(v[k] >> 16); } }
  int s = 0;
#pragma unroll
  for (int i = 0; i < PER; ++i) s += cnt[i];
  int S = s;
#pragma unroll
  for (int off = 1; off < 64; off <<= 1) { const int t = __shfl_down(S, off); if (lane + off < 64) S += t; }
  const bool is = (S >= need) && (S - s < need);
  int mybin = 0, myabove = 0;
  {
    int run = S - s; bool done = false;
#pragma unroll
    for (int i = PER - 1; i >= 0; --i) { if (!done) { if (run + cnt[i] >= need) { mybin = lane * PER + i; myabove = run; done = true; } else run += cnt[i]; } }
  }
  const unsigned long long bal = __ballot(is);
  const int src = bal ? (__ffsll((long long)bal) - 1) : 0;
  bin = __shfl(mybin, src); above = __shfl(myabove, src);
}

typedef short s16x2 __attribute__((ext_vector_type(2)));
__device__ __forceinline__ float dot2_relu(float x0, float x1, float wpair  , float acc) {
  const f32x2 v = {x0, x1}; const s16x2 pi = __builtin_bit_cast(s16x2, __builtin_convertvector(v, bf16x2_t)); const s16x2 z = {0, 0};
  return __builtin_amdgcn_fdot2_f32_bf16(__builtin_bit_cast(bf16x2_t, __builtin_elementwise_max(pi, z)), __builtin_bit_cast(bf16x2_t, wpair), acc, false);
}
__device__ __forceinline__ void wr_lane2(int& a, int& b, int lo, int hi, int lane_sel) {
  asm volatile("s_mov_b32 m0, %4\n\ts_nop 0\n\tv_writelane_b32 %0, %2, m0\n\tv_writelane_b32 %1, %3, m0" : "+v"(a), "+v"(b) : "s"(lo), "s"(hi), "s"(lane_sel) : "m0");
}
__device__ __forceinline__ int wave_incl_scan(int v) {
  v += __builtin_amdgcn_update_dpp(0, v, 0x111, 0xF, 0xF, false);
  v += __builtin_amdgcn_update_dpp(0, v, 0x112, 0xF, 0xF, false);
  v += __builtin_amdgcn_update_dpp(0, v, 0x114, 0xF, 0xF, false);
  v += __builtin_amdgcn_update_dpp(0, v, 0x118, 0xF, 0xF, false);
  v += __builtin_amdgcn_update_dpp(0, v, 0x142, 0xA, 0xF, false);
  v += __builtin_amdgcn_update_dpp(0, v, 0x143, 0xC, 0xF, false);
  return v;
}
#ifndef DSA_SKEW_MASK
#define DSA_SKEW_MASK 0
#endif
constexpr int DSA_E0S = 118 << 5;
__device__ __forceinline__ unsigned dsa_sub9(unsigned u, int t_) {
  const unsigned a = u & 0x7fffffffu;
  const int over = t_ - 511;
  const unsigned sub = t_ <= 0 ? (a >> 21) : (t_ >= 511 ? (unsigned)(over > 511 ? 511 : over) : ((a >> 9) & 511u));
  return (u >> 31) ? 511u - sub : sub;
}
__device__ __forceinline__ float relu_f(float x) { float r; asm("v_max_f32_e32 %0, 0, %1" : "=v"(r) : "v"(x)); return r; }
template <int MODE, bool MASKED, int ABL = 0>
__device__ __forceinline__ void dsa_tile(const f32x16& C, int k0, int qw, const f32x4 (&wq)[4], const int (&b1)[4], const int (&T19)[4], const int (&rtie)[4],
                                         int (&outcnt)[4], int (&tiecnt)[4], int (&gtm)[8], unsigned* hist, u16* idxl, int l31, int hh) {
  const int kabs = k0 + l31;
  const int tl = __builtin_amdgcn_readfirstlane((k0 >> 5) & 63);
#pragma unroll
  for (int g = 0; g < 4; ++g) {
    const float sc = __builtin_fmaf(wq[g][3], relu_f(C[4 * g + 3]), __builtin_fmaf(wq[g][2], relu_f(C[4 * g + 2]), __builtin_fmaf(wq[g][1], relu_f(C[4 * g + 1]), __builtin_fmaf(wq[g][0], relu_f(C[4 * g]), 0.f))));
    const unsigned u = __float_as_uint(sc);
    const int t_ = (int)__builtin_amdgcn_ubfe(u, 18, 13) - DSA_E0S;
    const int ix_ = t_ < 0 ? 0 : (t_ > 511 ? 511 : t_);
    const int bin = 512 + (ix_ ^ ((int)u >> 31));
    const bool valid = MASKED ? (kabs <= qw + 2 * g + hh) : true;
    unsigned* hq = hist + (2 * g + hh) * 512;
    if (MODE == 1) { if (valid) {
      if (ABL & 32) __hip_atomic_store(hq + (bin >> 1), 1u << ((bin & 1) * 16), __ATOMIC_RELAXED, __HIP_MEMORY_SCOPE_WORKGROUP);
      else atomicAdd(hq + (bin >> 1), 1u << ((bin & 1) * 16));
    } }
    else {
      const bool gt = valid && bin > b1[g], eq = valid && bin == b1[g];
      const unsigned long long bs = __ballot(gt);
      wr_lane2(gtm[2 * g], gtm[2 * g + 1], __builtin_amdgcn_readfirstlane((int)(unsigned)bs), __builtin_amdgcn_readfirstlane((int)(unsigned)(bs >> 32)), tl);
      const unsigned long long bc = __ballot(eq);
      if (bc) {
        const unsigned below = (1u << l31) - 1u;
        const unsigned hc = (unsigned)(hh ? (bc >> 32) : bc);
        const int cpos = tiecnt[g] + (int)__popc(hc & below);
        if (eq) {
          const unsigned ent = (dsa_sub9(u, t_) << 16) | (unsigned)kabs;
          if (cpos < 128) ((unsigned*)((char*)idxl + 4096))[(2 * g + hh) * 128 + cpos] = ent;
          else if (cpos < 2048) __hip_atomic_store(hist + ((unsigned)(2 * g * 2048) + (unsigned)(hh * 2048) + (unsigned)cpos), ent, __ATOMIC_RELAXED, __HIP_MEMORY_SCOPE_AGENT);
        }
        tiecnt[g] += (int)__popc(hc);
      }
    }
  }
}
template <int MODE, int ABL = 0>
__device__ __forceinline__ void dsa_valu(const f32x16& C0, const f32x16& C1, int kb, int tmaxw, int qw, const f32x4 (&wq)[4], const int (&b1)[4], const int (&T19)[4], const int (&rtie)[4],
                                         int (&outcnt)[4], int (&tiecnt)[4], int (&gtm)[8], unsigned* hist, u16* idxl, int lane) {
  const int l31 = lane & 31, hh = lane >> 5;
  if (kb + 31 <= qw) dsa_tile<MODE, false, ABL>(C0, kb, qw, wq, b1, T19, rtie, outcnt, tiecnt, gtm, hist, idxl, l31, hh);
  else dsa_tile<MODE, true, ABL>(C0, kb, qw, wq, b1, T19, rtie, outcnt, tiecnt, gtm, hist, idxl, l31, hh);
  if (kb + 32 <= tmaxw) {
    if (kb + 63 <= qw) dsa_tile<MODE, false, ABL>(C1, kb + 32, qw, wq, b1, T19, rtie, outcnt, tiecnt, gtm, hist, idxl, l31, hh);
    else dsa_tile<MODE, true, ABL>(C1, kb + 32, qw, wq, b1, T19, rtie, outcnt, tiecnt, gtm, hist, idxl, l31, hh);
  }
}
template <int MODE, int ABL = 0>
__device__ __forceinline__ void dsa_pass(char* lds, const u16* __restrict__ kig, int klast, int tmaxw, int qw, const bf16x8 (&qf)[4], const f32x4 (&wq)[4],
                                         const int (&b1)[4], const int (&T19)[4], const int (&rtie)[4], unsigned* hist, u16* idxl, int tid, int lane, int (&outcnt)[4], int (&tiecnt)[4]) {
#pragma unroll
  for (int g = 0; g < 4; ++g) { outcnt[g] = 0; tiecnt[g] = 0; }
  int gtm[8] = {0, 0, 0, 0, 0, 0, 0, 0};
  unsigned* bm = (unsigned*)((char*)idxl + 8192);
  if (MODE == 4) {
#pragma unroll
    for (int i = 0; i < 8; ++i) *(u32x4*)(bm + (i * 64 + lane) * 4) = (u32x4){0u, 0u, 0u, 0u};
  }
#define DSA_FLUSH(W) do { _Pragma("unroll") for (int q_ = 0; q_ < 8; ++q_) { bm[q_ * 256 + (W) * 64 + lane] = (unsigned)gtm[q_]; gtm[q_] = 0; } } while (0)
  if (MODE < 3) {
#pragma unroll
    for (int i = 0; i < 16; ++i) *(u32x4*)(hist + (i * 64 + lane) * 4) = (u32x4){0u, 0u, 0u, 0u};
  }
  asm volatile("" : "+v"(tid), "+v"(lane));
  const u16* src = kig + (size_t)(tid >> 3) * 64 + (tid & 7) * 8;
  const unsigned dsto = kimg_off(tid >> 3, tid & 7);
  const int l31 = lane & 31, hh = lane >> 5, ksw = (l31 >> 1) & 7;
  const unsigned koff = (unsigned)(l31 * 128);
  const f32x16 Z = {0.f, 0.f, 0.f, 0.f, 0.f, 0.f, 0.f, 0.f, 0.f, 0.f, 0.f, 0.f, 0.f, 0.f, 0.f, 0.f};
  f32x16 P0 = Z, P1 = Z;
#define DSA_LD(KB) (*(const u32x4*)(src + (size_t)((KB) < SEQ - 64 ? (KB) : SEQ - 64) * 64))
  u32x4 cr0 = DSA_LD(0), cr1 = DSA_LD(64), cr2 = DSA_LD(128), cr3 = DSA_LD(192), cr4 = DSA_LD(256), cr5 = DSA_LD(320);
  const bool late = (__builtin_amdgcn_readfirstlane(tid >> 6) & DSA_SKEW_MASK) != 0;
#define DSA_MFMAS() do { P0 = MFMA32(qf[0], kf[0][0], Z); P1 = MFMA32(qf[0], kf[1][0], Z); \
    _Pragma("unroll") for (int kk = 1; kk < 4; ++kk) { P0 = MFMA32(qf[kk], kf[0][kk], P0); P1 = MFMA32(qf[kk], kf[1][kk], P1); } } while (0)
#define DSA_STEP(CR, BUFI, KB) do { const int kb = (KB); \
    char* buf = lds + DSA_KI + (BUFI) * 8192; \
    *(u32x4*)(buf + dsto) = CR; \
    __syncthreads(); \
    CR = DSA_LD(kb + 384); \
    bf16x8 kf[2][4]; \
    _Pragma("unroll") for (int sub = 0; sub < 2; ++sub) _Pragma("unroll") for (int kk = 0; kk < 4; ++kk) kf[sub][kk] = *(const bf16x8*)(buf + 32 * sub * 128 + koff + (((hh + 2 * kk) ^ ksw) << 4)); \
    if (late) DSA_MFMAS(); \
    const int kp = late ? kb : kb - 64; \
    if (!(ABL & 8) && kp >= 0 && kp <= tmaxw) dsa_valu<MODE, ABL>(P0, P1, kp, tmaxw, qw, wq, b1, T19, rtie, outcnt, tiecnt, gtm, hist, idxl, lane); \
    if (MODE == 4 && kp >= 0 && ((kp + 64) & 2047) == 0 && kp + 64 <= tmaxw) DSA_FLUSH(kp >> 11); \
    if (!late) DSA_MFMAS(); } while (0)
  for (int kb6 = 0; kb6 <= klast; kb6 += 384) {
    DSA_STEP(cr0, 0, kb6); DSA_STEP(cr1, 1, kb6 + 64); DSA_STEP(cr2, 0, kb6 + 128);
    DSA_STEP(cr3, 1, kb6 + 192); DSA_STEP(cr4, 0, kb6 + 256); DSA_STEP(cr5, 1, kb6 + 320);
  }
#undef DSA_STEP
#undef DSA_MFMAS
#undef DSA_LD
  { const int kbl = (klast / 384) * 384 + 320; if (!late && !(ABL & 8) && kbl <= tmaxw) dsa_valu<MODE, ABL>(P0, P1, kbl, tmaxw, qw, wq, b1, T19, rtie, outcnt, tiecnt, gtm, hist, idxl, lane); }
  if (MODE == 4) DSA_FLUSH(tmaxw >> 11);
#undef DSA_FLUSH
  __syncthreads();
}

__device__ __forceinline__ unsigned pk4_fp8(float a, float b, float c, float d) { int w = 0; w = __builtin_amdgcn_cvt_pk_fp8_f32(a, b, w, false); w = __builtin_amdgcn_cvt_pk_fp8_f32(c, d, w, true); return (unsigned)w; }
__device__ __forceinline__ u32x2 fp8x4_bf16(unsigned w) {
#if defined(__HIP_DEVICE_COMPILE__)
  return (u32x2){__builtin_bit_cast(unsigned, __builtin_amdgcn_cvt_scalef32_pk_bf16_fp8(w, 1.0f, false)), __builtin_bit_cast(unsigned, __builtin_amdgcn_cvt_scalef32_pk_bf16_fp8(w, 1.0f, true))};
#else
  return (u32x2){w, w};
#endif
}
template <int ABL = 0>
__device__ __forceinline__ void dsa_unit(char* lds, const Params& p, int b, int tile, u16* outbuf) {
  const int tid = threadIdx.x, lane = tid & 63, wid = __builtin_amdgcn_readfirstlane(tid >> 6);
  const int l31 = lane & 31, hh = lane >> 5;
  unsigned char* ws = p.ws;
  const size_t tb = (size_t)b * SEQ;
  const int q0 = tile * 64, qw = q0 + wid * 8;
  char* R = lds + wid * 16384;
  unsigned* hist = (unsigned*)R;
  u16* idxl = (u16*)R;
  char* vst = R + 4096;
  const u16* kig = (const u16*)(ws + L0_KI) + tb * 64;
  bf16x8 qf[4];
  { const u16* qr = (const u16*)(ws + L0_QI) + (tb + qw + (l31 >> 2)) * 256 + (l31 & 3) * 64 + 8 * hh;
#pragma unroll
    for (int kk = 0; kk < 4; ++kk) qf[kk] = *(const bf16x8*)(qr + 16 * kk); }
  f32x4 wq[4];
#pragma unroll
  for (int g = 0; g < 4; ++g) wq[g] = *(const f32x4*)((const float*)(ws + L0_WI) + (tb + qw + 2 * g + hh) * 4);
  int b1[4] = {0, 0, 0, 0}, T19[4] = {0, 0, 0, 0}, rtie[4] = {0, 0, 0, 0}, need2[4] = {0, 0, 0, 0};
  const int klast = q0 + 63, tmaxw = qw + 7;
  int oc[4], tc[4];
  unsigned* cand = (unsigned*)(ws + L0_CAND) + ((size_t)blockIdx.x * 8 + wid) * 16384;
  if (!(ABL & 2)) dsa_pass<1, ABL>(lds, kig, klast, tmaxw, qw, qf, wq, b1, T19, rtie, hist, idxl, tid, lane, oc, tc);
#pragma unroll
  for (int g = 0; g < 4; ++g) {
    int bA, aA, bB, aB;
    find_bin<1024>(hist + (2 * g) * 512, 256, lane, bA, aA);
    find_bin<1024>(hist + (2 * g + 1) * 512, 256, lane, bB, aB);
    b1[g] = hh ? bB : bA; need2[g] = 256 - (hh ? aB : aA);
    if (qw + 2 * g + hh + 1 <= 256) { b1[g] = -1; need2[g] = 0; }
  }
  if (!(ABL & 4)) dsa_pass<4, ABL>(lds, kig, klast, tmaxw, qw, qf, wq, b1, T19, rtie, cand, idxl, tid, lane, oc, tc);
  asm volatile("s_waitcnt vmcnt(0) lgkmcnt(0)" ::: "memory");
  if (!(ABL & 16)) {
    int lane_r = lane; asm volatile("" : "+v"(lane_r));
    unsigned* bm = (unsigned*)(R + 8192);
    const unsigned* candl = (const unsigned*)(R + 4096);
    const unsigned long long lt = (1ull << lane_r) - 1ull;
    for (int q = 0; q < 8; ++q) {
      const int g = q >> 1, src = (q & 1) * 32;
      const int ncr = __shfl(g == 0 ? tc[0] : g == 1 ? tc[1] : g == 2 ? tc[2] : tc[3], src);
      const int nd = __shfl(g == 0 ? need2[0] : g == 1 ? need2[1] : g == 2 ? need2[2] : need2[3], src);
      unsigned* h2 = bm + q * 256;
      int pos;
      {
        const u32x4 wv = *(const u32x4*)(h2 + lane_r * 4);
        unsigned long long w0 = ((unsigned long long)wv.y << 32) | wv.x, w1 = ((unsigned long long)wv.w << 32) | wv.z;
        const int c = (int)__popcll(w0) + (int)__popcll(w1);
        const int incl = wave_incl_scan(c);
        int base = incl - c; pos = __builtin_amdgcn_readlane(incl, 63);
        const int k0_ = lane_r * 128;
        while (w0) { const int b_ = __ffsll((long long)w0) - 1; w0 &= w0 - 1ull; if (base < 256) idxl[q * 256 + base] = (u16)(k0_ + b_); ++base; }
        while (w1) { const int b_ = __ffsll((long long)w1) - 1; w1 &= w1 - 1ull; if (base < 256) idxl[q * 256 + base] = (u16)(k0_ + 64 + b_); ++base; }
      }
      if (nd <= 0) continue;
      const int nc = ncr < 2048 ? ncr : 2048;
      const unsigned* cq = cand + q * 2048;
      *(u32x4*)(h2 + lane_r * 4) = (u32x4){0u, 0u, 0u, 0u};
      asm volatile("" ::: "memory");
      for (int i0 = 0; i0 < nc; i0 += 64) {
        const int i = i0 + lane_r;
        unsigned e;
        if (i0 < 128) e = candl[q * 128 + (i & 127)]; else e = __hip_atomic_load(cq + (i < nc ? i : 0), __ATOMIC_RELAXED, __HIP_MEMORY_SCOPE_AGENT);
        const unsigned sub = e >> 16; if (i < nc) atomicAdd(h2 + (sub >> 1), 1u << ((sub & 1) * 16));
      }
      asm volatile("s_waitcnt lgkmcnt(0)" ::: "memory");
      int b2, a2; find_bin<512>(h2, nd, lane_r, b2, a2);
      const int r = nd - a2; int ties = 0;
      for (int i0 = 0; i0 < nc; i0 += 64) {
        const int i = i0 + lane_r; const bool in = i < nc;
        unsigned e;
        if (i0 < 128) e = candl[q * 128 + (i & 127)]; else e = __hip_atomic_load(cq + (in ? i : 0), __ATOMIC_RELAXED, __HIP_MEMORY_SCOPE_AGENT);
        const int sub = (int)(e >> 16);
        const bool tie = in && sub == b2;
        const unsigned long long bt = __ballot(tie);
        const bool sel = (in && sub > b2) || (tie && (ties + (int)__popcll(bt & lt) < r));
        ties += (int)__popcll(bt);
        const unsigned long long bs = __ballot(sel);
        const int pp = pos + (int)__popcll(bs & lt);
        if (sel && pp < 256) idxl[q * 256 + pp] = (u16)(e & 0xffffu);
        pos += (int)__popcll(bs);
      }
    }
  }
  const unsigned char* kva8 = ws + L0_KVA + tb * 256;
  const float kbound = 8.f * 1.15f * wave_max(fabsf(p.in[I_A_QKN][64 + lane]));
  u32x4 ring[4][4];
  bf16x8 qn0, qn1;
#define DSA_KISSUE(slot, qi_, g2) do { const int cn_ = (qw + (qi_) + 1 < 256) ? qw + (qi_) + 1 : 256; _Pragma("unroll") for (int k2 = 0; k2 < 2; ++k2) { const int e_ = 32 * (g2) + 16 * k2 + (lane_o & 15); \
      const int tok_ = e_ < cn_ ? (int)idxl[(qi_) * 256 + e_] : 0; const unsigned char* kr_ = kva8 + (size_t)tok_ * 256 + 16 * (lane_o >> 4); \
      ring[slot][2 * k2] = *(const u32x4*)kr_; ring[slot][2 * k2 + 1] = *(const u32x4*)(kr_ + 64); } } while (0)
#define DSA_VISSUE(slot, qi_, s2_) do { const int cn_ = (qw + (qi_) + 1 < 256) ? qw + (qi_) + 1 : 256; _Pragma("unroll") for (int j = 0; j < 4; ++j) { const int e_ = 32 * (s2_) + 8 * j + (lane_o >> 3); \
      const int tok_ = e_ < cn_ ? (int)idxl[(qi_) * 256 + e_] : 0; ring[slot][j] = *(const u32x4*)(kva8 + (size_t)tok_ * 256 + 128 + 16 * (lane_o & 7)); } } while (0)
#define DSA_QISSUE(qi_) do { const u16* qr_ = (const u16*)(ws + L0_QA) + (tb + qw + (qi_)) * 512 + (lane_o & 7) * 64 + 16 * (lane_o >> 4); qn0 = *(const bf16x8*)qr_; qn1 = *(const bf16x8*)(qr_ + 8); } while (0)
  if (!(ABL & 1)) { int lane_o = lane; asm volatile("" : "+v"(lane_o)); DSA_QISSUE(0); DSA_KISSUE(0, 0, 0); DSA_KISSUE(1, 0, 1); DSA_KISSUE(2, 0, 2); }
#pragma unroll 1
  for (int qq = 0; qq < ((ABL & 1) ? 0 : 8); ++qq) {
    int lane_o = lane; asm volatile("" : "+v"(lane_o));
    const int fr = lane_o & 15, fq = lane_o >> 4;
    const int t = qw + qq, cnt = t + 1 < 256 ? t + 1 : 256;
    const int qnx = qq + 1 < 8 ? qq + 1 : 7;
    long qb[4]; float shift;
    {
      const bf16x8 qa0 = qn0, qa1 = qn1;
      float f0[8], f1[8], qn = 0.f;
#pragma unroll
      for (int j = 0; j < 8; ++j) { f0[j] = bf1((u16)qa0[j]); f1[j] = bf1((u16)qa1[j]); qn += f0[j] * f0[j] + f1[j] * f1[j]; }
      qn = rsum4(qn); shift = (fr < 8) ? __builtin_sqrtf(qn) * kbound : 0.f;
      const u32x2 lo = {pk4_fp8(f0[0] * 8.f, f0[1] * 8.f, f0[2] * 8.f, f0[3] * 8.f), pk4_fp8(f0[4] * 8.f, f0[5] * 8.f, f0[6] * 8.f, f0[7] * 8.f)};
      const u32x2 hi = {pk4_fp8(f1[0] * 8.f, f1[1] * 8.f, f1[2] * 8.f, f1[3] * 8.f), pk4_fp8(f1[4] * 8.f, f1[5] * 8.f, f1[6] * 8.f, f1[7] * 8.f)};
      const long q8lo = __builtin_bit_cast(long, lo), q8hi = __builtin_bit_cast(long, hi);
      qb[0] = fr < 4 ? q8lo : 0l; qb[1] = fr < 4 ? q8hi : 0l; qb[2] = (fr >= 4 && fr < 8) ? q8lo : 0l; qb[3] = (fr >= 4 && fr < 8) ? q8hi : 0l;
    }
    u32x2 pk[16]; float ls = 0.f;
#pragma unroll
    for (int grp = 0; grp < 8; ++grp) {
      if (grp + 3 < 8) DSA_KISSUE((grp + 3) & 3, qq, grp + 3); else DSA_VISSUE((grp + 3) & 3, qq, grp + 3 - 8);
      __builtin_amdgcn_sched_barrier(0);
#pragma unroll
      for (int k2 = 0; k2 < 2; ++k2) {
        f32x4 a = {0.f, 0.f, 0.f, 0.f};
#pragma unroll
        for (int pr = 0; pr < 2; ++pr) {
          const u32x4 kw = ring[grp & 3][2 * k2 + pr];
          a = __builtin_amdgcn_mfma_f32_16x16x32_fp8_fp8(__builtin_bit_cast(long, (u32x2){kw.x, kw.y}), qb[2 * pr], a, 0, 0, 0);
          a = __builtin_amdgcn_mfma_f32_16x16x32_fp8_fp8(__builtin_bit_cast(long, (u32x2){kw.z, kw.w}), qb[2 * pr + 1], a, 0, 0, 0);
        }
        float pv[4];
#pragma unroll
        for (int r = 0; r < 4; ++r) { pv[r] = (32 * grp + 16 * k2 + 4 * fq + r < cnt) ? __builtin_amdgcn_exp2f(__builtin_fmaf(a[r], 0.125f, -shift)) : 0.f; ls += pv[r]; }
        pk[2 * grp + k2] = (u32x2){cvtpk(pv[0], pv[1]), cvtpk(pv[2], pv[3])};
      }
      __builtin_amdgcn_sched_barrier(0);
    }
    ls = rsum4(ls);
    const float linv = __builtin_amdgcn_rcpf(ls);
    f32x4 o[8];
#pragma unroll
    for (int dt = 0; dt < 8; ++dt) o[dt] = (f32x4){0.f, 0.f, 0.f, 0.f};
    const int vk8 = lane_o >> 3, vc = lane_o & 7;
    DSA_QISSUE(qnx);
#pragma unroll
    for (int s2 = 0; s2 < 8; ++s2) {
#pragma unroll
      for (int j = 0; j < 4; ++j) { const int key = 8 * j + vk8; char* d_ = vst + key * 256 + ((vc ^ (key & 7)) << 5); const u32x4 vv = ring[s2 & 3][j];
        const u32x2 a0 = fp8x4_bf16(vv.x), a1 = fp8x4_bf16(vv.y), a2 = fp8x4_bf16(vv.z), a3 = fp8x4_bf16(vv.w);
        *(u32x4*)d_ = (u32x4){a0.x, a0.y, a1.x, a1.y}; *(u32x4*)(d_ + 16) = (u32x4){a2.x, a2.y, a3.x, a3.y}; }
      __builtin_amdgcn_sched_barrier(0);
      if (s2 + 3 < 8) DSA_VISSUE((s2 + 3) & 3, qq, s2 + 3); else DSA_KISSUE((s2 + 3) & 3, qnx, s2 + 3 - 8);
      __builtin_amdgcn_sched_barrier(0);
      u32x4 w; w.x = pk[2 * s2].x; w.y = pk[2 * s2].y; w.z = pk[2 * s2 + 1].x; w.w = pk[2 * s2 + 1].y;
      const bf16x8 pb = __builtin_bit_cast(bf16x8, w);
      const int vkey = 4 * fq + (fr >> 2);
#pragma unroll
      for (int dt = 0; dt < 8; ++dt) {
        const char* vb = vst + vkey * 256 + ((dt ^ (vkey & 7)) << 5) + (lane_o & 3) * 8;
        const char* vb2 = vst + (vkey + 16) * 256 + ((dt ^ ((vkey + 16) & 7)) << 5) + (lane_o & 3) * 8;
        const v4i16_t lo4 = tr_read(vb), hi4 = tr_read(vb2);
        const bf16x8 a = (bf16x8){lo4[0], lo4[1], lo4[2], lo4[3], hi4[0], hi4[1], hi4[2], hi4[3]};
        o[dt] = MFMA16(a, pb, o[dt]);
      }
      __builtin_amdgcn_sched_barrier(0);
    }
    if (fr < 8) {
      f32x4 od[4];
#pragma unroll
      for (int dt = 0; dt < 4; ++dt) od[dt] = (fr < 4 ? o[dt] : o[dt + 4]) * linv;
      gated_store(outbuf + (tb + t) * 1024 + fr * 64, od, fq);
    }
  }
  __syncthreads();
}
#define GAS __attribute__((address_space(1)))
#define XB_TMO      128
#define XB_XCNT(j)  (256  + 64 * (j))
#define XB_XSUB(j)  (1280 + 64 * (j))
#define XB_XGEN(j)  (2304 + 64 * (j))
#define XB_TOP      3328
#define XB_TOPGEN   3392
#define XCD_BAR_WORDS 3456
#define XB_SPIN_CAP (1u << 18)

__device__ __forceinline__ unsigned xb_ld(unsigned* p)              { return __hip_atomic_load(p, __ATOMIC_RELAXED, __HIP_MEMORY_SCOPE_AGENT); }
__device__ __forceinline__ unsigned xb_add(unsigned* p, unsigned v) { return __hip_atomic_fetch_add(p, v, __ATOMIC_RELAXED, __HIP_MEMORY_SCOPE_AGENT); }
__device__ __forceinline__ unsigned xb_xcc_id() { return (unsigned)__builtin_amdgcn_s_getreg((3 << 11) | 20) & 0xFu; }
#define XB_SPIN(cond, bar) do { unsigned _sp = 0; while (cond) { __builtin_amdgcn_s_sleep(1); \
    if ((++_sp & 255u) == 0u) { if (xb_ld(&(bar)[XB_TMO])) break; if (_sp > XB_SPIN_CAP) { atomicAdd(&(bar)[XB_TMO], 1u); break; } } } } while (0)

struct XcdBarrier {
    unsigned* bar; unsigned x;
    volatile LAS unsigned* st;
};

__device__ __forceinline__ XcdBarrier xcd_barrier_post(unsigned* bar, volatile LAS unsigned* st) {
    XcdBarrier b; b.bar = bar; b.x = xb_xcc_id(); b.st = st;
    if (threadIdx.x == 0) (void)xb_add(&bar[XB_XCNT(b.x)], 1u);
    return b;
}
__device__ __forceinline__ void xcd_barrier_complete(unsigned* bar, unsigned x, unsigned& nloc, unsigned& nx) {
    const unsigned G = gridDim.x * gridDim.y * gridDim.z;
    unsigned sum, cnt, mine, sp = 0u;
    for (;;) {
        sum = 0u; cnt = 0u; mine = 0u;
#pragma unroll
        for (unsigned j = 0; j < 16; ++j) { const unsigned c = xb_ld(&bar[XB_XCNT(j)]); sum += c; cnt += (c > 0u) ? 1u : 0u; mine = (j == x) ? c : mine; }
        if (sum == G) break;
        __builtin_amdgcn_s_sleep(1);
        if ((++sp & 255u) == 0u) { if (xb_ld(&bar[XB_TMO])) break; if (sp > XB_SPIN_CAP) { atomicAdd(&bar[XB_TMO], 1u); break; } }
    }
    nloc = mine > 0u ? mine : 1u; nx = cnt > 0u ? cnt : 1u;
}

__device__ __forceinline__ void xcd_barrier(const XcdBarrier& b) {
    asm volatile("s_waitcnt vmcnt(0)" ::: "memory");
    __syncthreads();
    if (threadIdx.x == 0) {
        unsigned* bar = b.bar;
        __builtin_amdgcn_s_waitcnt(0);
        unsigned nloc = b.st[0], nx = b.st[1];
        if (nloc == 0u) { xcd_barrier_complete(bar, b.x, nloc, nx); b.st[0] = nloc; b.st[1] = nx; }
        const unsigned old = xb_add(&bar[XB_XSUB(b.x)], 1u);
        const unsigned gen = old / nloc;
        if (old + 1u == (gen + 1u) * nloc) {
            __builtin_amdgcn_fence(__ATOMIC_RELEASE, "agent");
            asm volatile("s_waitcnt vmcnt(0)" ::: "memory");
            const unsigned og = xb_add(&bar[XB_TOP], 1u);
            const unsigned tg = og / nx;
            if (og + 1u == (tg + 1u) * nx) xb_add(&bar[XB_TOPGEN], 1u);
            else XB_SPIN(xb_ld(&bar[XB_TOPGEN]) == tg, bar);
            __builtin_amdgcn_fence(__ATOMIC_ACQUIRE, "agent");
            xb_add(&bar[XB_XGEN(b.x)], 1u);
            asm volatile("s_waitcnt vmcnt(0)" ::: "memory");
        } else {
            XB_SPIN(xb_ld(&bar[XB_XGEN(b.x)]) == gen, bar);
            __builtin_amdgcn_fence(__ATOMIC_ACQUIRE, "agent");
            asm volatile("s_waitcnt vmcnt(0)" ::: "memory");
        }
    }
    __syncthreads();
}
constexpr int LDS_BYTES = 163840;
static_assert(LDS_BYTES >= DSA_LDS && LDS_BYTES >= pg8::STAGE_BYTES && LDS_BYTES >= NSA_LDS && LDS_BYTES >= 8 * 8704, "LDS budget");

constexpr size_t WS_CTR = WS_BAR + 14 * 1024;
__device__ __forceinline__ int grab_unit(unsigned* ctr, char* lds) {
  volatile int* slot = (volatile int*)(lds + LDS_BYTES - 32);
  if (threadIdx.x == 0) *slot = (int)__hip_atomic_fetch_add(ctr, 1u, __ATOMIC_RELAXED, __HIP_MEMORY_SCOPE_AGENT);
  __syncthreads();
  const int u = *slot;
  __syncthreads();
  return u;
}
#define RUN0 if (p.ph_hi > 0) { phase0(p, lds); }
#define RUN1 if (p.ph_hi > 1) { EpiProj<0> e{ws, p.in}; run_gemm(lds, (const u16*)(ws + WS_XB), (const u16*)(ws + WS_W0T), T, AB_N, DM, e, 46); }
#define RUN2 if (p.ph_hi > 2) { if (G == 256) { unsigned* ctr = (unsigned*)(ws + WS_CTR); \
                 for (;;) { const int u = grab_unit(ctr + (v >> 6) * 16, lds); if (u >= 128) break; dsa_unit<0>(lds, p, v >> 6, 127 - u, (u16*)(ws + WS_MIX)); } \
                 for (;;) { const int u = grab_unit(ctr + 128 + (v >> 5) * 16, lds); if (u >= 128) break; swa_unit(lds, p, v >> 6, (v >> 5) & 1, 127 - u); } } \
               else { for (int u = v; u < 256; u += G) { const int b = u >> 6, pi = u & 63; for (int i = 0; i < 2; ++i) dsa_unit<0>(lds, p, b, i == 0 ? pi : 127 - pi, (u16*)(ws + WS_MIX)); } \
                 for (int u = v; u < 1024; u += G) swa_unit(lds, p, u >> 8, (u >> 7) & 1, u & 127); } }
#define RUN2D if (p.ph_hi > 2) { for (int u = v; u < 256; u += G) { const int b = u >> 6, pi = u & 63; for (int i = 0; i < 2; ++i) dsa_unit<0>(lds, p, b, i == 0 ? pi : 127 - pi, (u16*)(ws + WS_MIX)); } }
#define RUN2S if (p.ph_hi > 2) { for (int u = v; u < 1024; u += G) swa_unit(lds, p, u >> 8, (u >> 7) & 1, u & 127); }
#define RUN6M if (p.ph_hi > 6) { MLA_LOOP(0, WS_MIX) }
#define RUN6N if (p.ph_hi > 6) { for (int u = v; u < 256; u += G) { const int b = u >> 6, kvh = (u >> 5) & 1, pi = u & 31; \
                 for (int i = 0; i < 4; ++i) { const int tl = (i == 0) ? 127 - pi : (i == 1) ? 64 + pi : (i == 2) ? 63 - pi : pi; nsa_unit<0>(lds, p, b, kvh, tl, (u16*)(ws + WS_MIX)); } } }
#ifndef XABL
#define XABL 0
#endif
#define RUNX if (p.ph_hi > 6) { MLA_LOOP(XABL, WS_XB) }
#define RUN2X if (p.ph_hi > 2) { for (int u = v; u < 256; u += G) { const int b = u >> 6, pi = u & 63; for (int i = 0; i < 2; ++i) dsa_unit<XABL>(lds, p, b, i == 0 ? 127 - pi : pi, (u16*)(ws + WS_XB)); } }
#define RUNG if (p.ph_hi > 1) { EpiNull e{(float*)(ws + WS_SSQ1P)}; run_gemm(lds, (const u16*)(ws + WS_XB), (const u16*)(ws + WS_W0T), T, AB_N, DM, e, 48); }
#define RUNXN if (p.ph_hi > 6) { for (int u = v; u < 256; u += G) { const int b = u >> 6, kvh = (u >> 5) & 1, pi = u & 31; \
                 for (int i = 0; i < 4; ++i) { const int tl = (i == 0) ? 127 - pi : (i == 1) ? 64 + pi : (i == 2) ? 63 - pi : pi; nsa_unit<XABL>(lds, p, b, kvh, tl, (u16*)(ws + WS_XB)); } } }
#define RUN3 if (p.ph_hi > 3) { EpiOut<0> e{ws, p.in[I_X], p.out}; run_gemm(lds, (const u16*)(ws + WS_MIX), (const u16*)(ws + WS_WO0T), T, DM, DM, e, 16); }
#define RUN4 if (p.ph_hi > 4) { EpiProj<1> e{ws, p.in}; run_gemm(lds, (const u16*)(ws + WS_XB), (const u16*)(ws + WS_W1T), T, CD_N, DM, e, 44); }
#define RUN5 if (p.ph_hi > 5) { for (int u = v; u < 256; u += G) cmp_unit(lds, p, u >> 7, u & 127); } \
             if (p.ph_hi > 5) { EpiUp<0> e{ws, p.in}; run_gemm(lds, (const u16*)(ws + L1_CQ), (const u16*)(ws + WS_WUQT), T, 768, 256, e, 12); } \
             if (p.ph_hi > 5) { EpiUp<1> e{ws, p.in}; run_gemm(lds, (const u16*)(ws + L1_CKV), (const u16*)(ws + WS_WUKVT), T, 1024, 128, e, 16); }
#define RUN5A if (p.ph_hi > 5) { for (int u = v; u < 256; u += G) cmp_unit(lds, p, u >> 7, u & 127); }
#define RUN5B if (p.ph_hi > 5) { EpiUp<0> e{ws, p.in}; run_gemm(lds, (const u16*)(ws + L1_CQ), (const u16*)(ws + WS_WUQT), T, 768, 256, e, 12); }
#define RUN5C if (p.ph_hi > 5) { EpiUp<1> e{ws, p.in}; run_gemm(lds, (const u16*)(ws + L1_CKV), (const u16*)(ws + WS_WUKVT), T, 1024, 128, e, 16); }
#define MLA_LOOP(ABL_, OUT_) for (int u = v; u < 256; u += G) { const int bh = u >> 3, i = u & 7; \
                 for (int r = 0; r < 2; ++r) { const int qb = (r == 0) ? 15 - i : i; \
                   mla_unit<ABL_>(lds, p, bh >> 3, bh & 7, qb, (u16*)(ws + OUT_)); } }
#define RUN6 if (p.ph_hi > 6) { if (G == 256) { unsigned* ctr = (unsigned*)(ws + WS_CTR); \
                 for (;;) { const int u = grab_unit(ctr + 256 + (v >> 5) * 16, lds); if (u >= 64) break; const int bh = 4 * (v >> 5) + (u & 3); mla_unit<0>(lds, p, bh >> 3, bh & 7, 15 - (u >> 2), (u16*)(ws + WS_MIX)); } \
                 for (;;) { const int u = grab_unit(ctr + 384 + (v >> 5) * 16, lds); if (u >= 128) break; nsa_unit<0>(lds, p, v >> 6, (v >> 5) & 1, 127 - u, (u16*)(ws + WS_MIX)); } } \
               else { MLA_LOOP(0, WS_MIX) \
                 for (int u = v; u < 256; u += G) { const int b = u >> 6, kvh = (u >> 5) & 1, pi = u & 31; \
                   for (int i = 0; i < 4; ++i) { const int tl = (i == 0) ? 127 - pi : (i == 1) ? 64 + pi : (i == 2) ? 63 - pi : pi; nsa_unit<0>(lds, p, b, kvh, tl, (u16*)(ws + WS_MIX)); } } } }
#define RUN7 if (p.ph_hi > 7) { EpiOut<1> e{ws, p.in[I_X], p.out}; run_gemm(lds, (const u16*)(ws + WS_MIX), (const u16*)(ws + WS_WO1T), T, DM, DM, e, 16); }
#define SYNC xcd_barrier(bar);
#define SYNC0 grid.sync();
#ifndef PROGRAM
#define PROGRAM RUN0 SYNC0 RUN1 SYNC RUN2 SYNC RUN3 SYNC RUN4 SYNC RUN5 SYNC RUN6 SYNC RUN7
#endif
__global__ void __launch_bounds__(512) mega_fwd(Params p) {
  extern __shared__ __attribute__((aligned(16))) char smem[];
  cg::grid_group grid = cg::this_grid();
  char* lds = smem;
  unsigned char* ws = p.ws;
  const int G = gridDim.x, v = vblock();
  volatile LAS unsigned* bst = (volatile LAS unsigned*)(LAS unsigned char*)(smem + LDS_BYTES - 16);
  if (threadIdx.x < 2) bst[threadIdx.x] = 0u;
  __syncthreads();
  XcdBarrier bar = xcd_barrier_post((unsigned*)(ws + WS_BAR), bst);
  PROGRAM
#if defined(DSA_CHECK) || defined(DSA_CHECK2)
  xcd_barrier(bar);
  { const float c = 1000.f * (1.f + (float)*(volatile unsigned*)(ws + WS_BAR + 15 * 1024));
    const float c2 = 10000.f * (1.f + (float)*(volatile unsigned*)(ws + WS_BAR + 15 * 1024 + 256));
    for (size_t i = (size_t)blockIdx.x * 512 + threadIdx.x; i < (size_t)T * DM; i += (size_t)G * 512) p.out[i] = (i == 0) ? c2 : c; }
#endif
}

#ifndef N_LAUNCHES
#define N_LAUNCHES 1
#endif
extern "C" void kernel_launch(void* const* d_in, const int* in_sizes, int n_in, void* d_out, int out_size, void* d_ws, size_t ws_size, hipStream_t stream) {
  static int grid_blocks = 0;
  if (grid_blocks == 0) {
    if (n_in != 22 || out_size != T * DM || ws_size < WS_NEED) { fprintf(stderr, "kernel_launch: unexpected problem (n_in %d, out %d, ws %zu < %zu)\n", n_in, out_size, ws_size, (size_t)WS_NEED); grid_blocks = -1; return; }
    int dev = 0, cus = 0, per_cu = 0;
    hipGetDevice(&dev);
    hipDeviceGetAttribute(&cus, hipDeviceAttributeMultiprocessorCount, dev);
    hipFuncSetAttribute((const void*)mega_fwd, hipFuncAttributeMaxDynamicSharedMemorySize, LDS_BYTES);
    hipOccupancyMaxActiveBlocksPerMultiprocessor(&per_cu, (const void*)mega_fwd, 512, LDS_BYTES);
    if (per_cu < 1) { fprintf(stderr, "kernel_launch: occupancy query says %d blocks per CU\n", per_cu); per_cu = 1; }
    grid_blocks = cus;
    if (grid_blocks > cus * per_cu) grid_blocks = cus * per_cu;
    grid_blocks &= ~7;
  }
  if (grid_blocks <= 0) return;
  if (hipMemsetAsync((char*)d_ws + WS_BAR, 0, 16384, stream) != hipSuccess) { fprintf(stderr, "kernel_launch: memset of the barrier words failed\n"); return; }
  Params p{};
  for (int i = 0; i < 22; ++i) p.in[i] = (const float*)d_in[i];
  p.out = (float*)d_out; p.ws = (unsigned char*)d_ws;
  for (int li = 0; li < N_LAUNCHES; ++li) {
    p.ph_lo = 0; p.ph_hi = 8;
    void* args[] = {&p};
    hipError_t e = hipLaunchCooperativeKernel((const void*)mega_fwd, dim3(grid_blocks), dim3(512), args, LDS_BYTES, stream);
    if (e != hipSuccess) fprintf(stderr, "cooperative launch failed: %s (grid %d)\n", hipGetErrorString(e), grid_blocks);
  }
}
```

```cpp
#include <hip/hip_runtime.h>
#include <hip/hip_cooperative_groups.h>
#include <cstdio>
#include <cstdint>
namespace cg = cooperative_groups;

typedef unsigned short u16;
typedef short bf16x8 __attribute__((ext_vector_type(8)));
typedef float f32x4 __attribute__((ext_vector_type(4)));
typedef float f32x2 __attribute__((ext_vector_type(2)));
typedef unsigned u32x4 __attribute__((ext_vector_type(4)));
typedef unsigned u32x2 __attribute__((ext_vector_type(2)));
typedef __bf16 bf16x2_t __attribute__((ext_vector_type(2)));
typedef short v4i16_t __attribute__((ext_vector_type(4)));
#define LAS __attribute__((address_space(3)))

constexpr int T = 32768, SEQ = 8192, DM = 1024, NB = 4;
constexpr int AB_N = 3072, CD_N = 2816;
constexpr float EPS = 1e-6f;
constexpr float LOG2E = 1.4426950408889634f;
constexpr float QS64 = 0.125f * LOG2E;
constexpr float QS96 = 0.10206207261596575f * LOG2E;

constexpr size_t MiB = 1048576;
constexpr size_t WS_W0T = 0;
constexpr size_t WS_WO0T = 6 * MiB;
constexpr size_t WS_W1T = 8 * MiB;
constexpr size_t WS_WO1T = 14 * MiB;
constexpr size_t WS_WUQT = 16 * MiB;
constexpr size_t WS_WUKVT = 16 * MiB + 512 * 1024;
constexpr size_t WS_WC1T = 17 * MiB;
constexpr size_t WS_WC2T = 18 * MiB;
constexpr size_t WS_CBIAS = 18 * MiB + 64 * 1024;
constexpr size_t WS_ROPE64 = 19 * MiB;
constexpr size_t WS_ROPE32 = 21 * MiB;
constexpr size_t WS_SSQ0 = 22 * MiB;
constexpr size_t WS_BAR = 22 * MiB + 768 * 1024;
constexpr size_t WS_SSQ1P = 23 * MiB;
constexpr size_t WS_XB = 26 * MiB;
constexpr size_t WS_MIX = 90 * MiB;
constexpr size_t WS_L = 154 * MiB;
constexpr size_t L0_QA = WS_L;
constexpr size_t L0_KVA = L0_QA + 32 * MiB;
constexpr size_t L0_QI = L0_KVA + 16 * MiB;
constexpr size_t L0_KI = L0_QI + 16 * MiB;
constexpr size_t L0_WI = L0_KI + 4 * MiB;
constexpr size_t L0_QB = L0_WI + 1 * MiB;
constexpr size_t L0_KVB = L0_QB + 32 * MiB;
constexpr size_t L0_IDX = L0_KVB + 16 * MiB;
constexpr size_t L0_CAND = L0_IDX + 16 * MiB;
constexpr size_t L0_END = L0_CAND + 128 * MiB;
constexpr size_t L1_QC = WS_L;
constexpr size_t L1_KCR = L1_QC + 32 * MiB;
constexpr size_t L1_VCR = L1_KCR + 8 * MiB;
constexpr size_t L1_KVS = L1_VCR + 8 * MiB;
constexpr size_t L1_KVW = L1_KVS + 16 * MiB;
constexpr size_t L1_GATES = L1_KVW + 16 * MiB;
constexpr size_t L1_CQ = L1_GATES + 3 * MiB;
constexpr size_t L1_CKV = L1_CQ + 16 * MiB;
constexpr size_t L1_SSQQ = L1_CKV + 8 * MiB;
constexpr size_t L1_SSQKV = L1_SSQQ + 1 * MiB;
constexpr size_t L1_KROPE = L1_SSQKV + 1 * MiB;
constexpr size_t L1_QM = L1_KROPE + 2 * MiB;
constexpr size_t L1_KN = L1_QM + 48 * MiB;
constexpr size_t L1_VM = L1_KN + 32 * MiB;
constexpr size_t L1_KCMP = L1_VM + 32 * MiB;
constexpr size_t L1_VCMP = L1_KCMP + 1 * MiB;
constexpr size_t L1_END = L1_VCMP + 1 * MiB;
constexpr size_t WS_NEED = (L1_END > L0_END ? L1_END : L0_END);

struct Params {
  const float* in[22];
  float* out;
  unsigned char* ws;
  int ph_lo, ph_hi;
};
enum { I_X = 0, I_AB_NORM, I_AB_WIN, I_A_QKN, I_A_KIDXN, I_B_QKN, I_B_SINKS, I_AB_WOUT, I_CD_NORM, I_CD_WIN, I_C_QN, I_C_KN, I_C_PE, I_C_W1, I_C_W2,
       I_D_QLN, I_D_KVLN, I_D_WUQ, I_D_WUKV, I_D_NOPEN, I_D_ROPEN, I_CD_WOUT };

__device__ __forceinline__ unsigned cvtpk(float lo, float hi) { f32x2 v = {lo, hi}; bf16x2_t b = __builtin_convertvector(v, bf16x2_t); return __builtin_bit_cast(unsigned, b); }
__device__ __forceinline__ float bflo(unsigned w) { return __uint_as_float(w << 16); }
__device__ __forceinline__ float bfhi(unsigned w) { return __uint_as_float(w & 0xffff0000u); }
__device__ __forceinline__ float bf1(u16 h) { return __uint_as_float((unsigned)h << 16); }
__device__ __forceinline__ float rsum4(float s) {
  auto a = __builtin_amdgcn_permlane16_swap(__float_as_uint(s), __float_as_uint(s), false, false); s = __uint_as_float(a[0]) + __uint_as_float(a[1]);
  auto b = __builtin_amdgcn_permlane32_swap(__float_as_uint(s), __float_as_uint(s), false, false); return __uint_as_float(b[0]) + __uint_as_float(b[1]); }
__device__ __forceinline__ float rmax4(float s) {
  auto a = __builtin_amdgcn_permlane16_swap(__float_as_uint(s), __float_as_uint(s), false, false); s = fmaxf(__uint_as_float(a[0]), __uint_as_float(a[1]));
  auto b = __builtin_amdgcn_permlane32_swap(__float_as_uint(s), __float_as_uint(s), false, false); return fmaxf(__uint_as_float(b[0]), __uint_as_float(b[1])); }
__device__ __forceinline__ float wave_sum(float v) {
#pragma unroll
  for (int o = 1; o < 64; o <<= 1) v += __shfl_xor(v, o);
  return v;
}
__device__ __forceinline__ float silu_f(float z) { return z * __builtin_amdgcn_rcpf(1.f + __builtin_amdgcn_exp2f(-z * LOG2E)); }
__device__ __forceinline__ float sigmoid_f(float z) { return __builtin_amdgcn_rcpf(1.f + __builtin_amdgcn_exp2f(-z * LOG2E)); }
#define MFMA16(a, b, c) __builtin_amdgcn_mfma_f32_16x16x32_bf16((a), (b), (c), 0, 0, 0)

struct MapId { __device__ static int f(int n) { return n; } };
struct MapAB { __device__ static int f(int n) { return n < 1092 ? n : ((n < 1152 || n >= 2944) ? -1 : n - 60); } };
struct MapCD { __device__ static int f(int n) {
  if (n < 1304) return n;
  if (n < 1344) return -1;
  if (n < 2272) return n - 40;
  if (n < 2304) return -1;
  return n - 72; } };
struct MapUQ { __device__ static int f(int n) { if (n < 512) return (n >> 6) * 96 + (n & 63); const int m = n - 512; return (m >> 5) * 96 + 64 + (m & 31); } };
struct MapUKV { __device__ static int f(int n) { if (n < 512) return (n >> 6) * 128 + (n & 63); const int m = n - 512; return (m >> 6) * 128 + 64 + (m & 63); } };

struct LayNone { __device__ static bool f(int) { return false; } };
struct LayCD { __device__ static bool f(int g) { return g == 35; } };
struct LayUQ { __device__ static bool f(int g) { return g >= 8; } };
template <class LA> __device__ __forceinline__ int perm256(int P) {
  const int wc = (P >> 5) & 3, bj = (P >> 7) & 1, n = (P >> 4) & 1, fq = (P >> 2) & 3, r = P & 3, g = (P >> 8) * 4 + wc;
  return (P & ~255) + 64 * wc + 32 * bj + (LA::f(g) ? 16 * n + 4 * fq : 8 * fq + 4 * n) + r;
}
template <class Map, bool PERM = false, class LA = LayNone>
__device__ __forceinline__ void conv_job(const float* __restrict__ W, int K, int ldsrc, u16* WT, int Ndst, const float* __restrict__ gain, float* scr, int lane, int& it0, int gw, int NGW) {
  const int nblk = Ndst / 32, nitems = (K / 64) * nblk;
  int first = gw - (it0 % NGW); if (first < 0) first += NGW;
  for (int it = first; it < nitems; it += NGW) {
    const int kb = it / nblk, nb = it % nblk, k0 = 64 * kb, n0 = 32 * nb;
    const int sc = Map::f(PERM ? perm256<LA>(n0 + (lane & 31)) : n0 + (lane & 31));
#pragma unroll 8
    for (int i = 0; i < 32; ++i) {
      const int kk = 2 * i + (lane >> 5);
      float v = 0.f;
      if (sc >= 0) { v = W[(size_t)(k0 + kk) * ldsrc + sc]; if (gain) v *= gain[k0 + kk]; }
      scr[kk * 33 + (lane & 31)] = v;
    }
    __builtin_amdgcn_wave_barrier();
    const int c = lane & 7;
#pragma unroll
    for (int j = 0; j < 4; ++j) {
      const int n = (lane >> 3) + 8 * j; const float* s = scr + (8 * c) * 33 + n;
      u32x4 o; o.x = cvtpk(s[0], s[33]); o.y = cvtpk(s[66], s[99]); o.z = cvtpk(s[132], s[165]); o.w = cvtpk(s[198], s[231]);
      *(u32x4*)(WT + (size_t)(n0 + n) * K + k0 + 8 * c) = o;
    }
    __builtin_amdgcn_wave_barrier();
  }
  it0 += nitems;
}

__device__ __forceinline__ void phase0(const Params& p, char* lds) {
  const int tid = threadIdx.x, lane = tid & 63, wid = tid >> 6;
  const int gw = blockIdx.x * 8 + wid, NGW = gridDim.x * 8;
  unsigned char* ws = p.ws;
  float* scr = (float*)(lds + wid * 8704);
  int it0 = 0;
  conv_job<MapAB, true>(p.in[I_AB_WIN], 1024, 2884, (u16*)(ws + WS_W0T), AB_N, p.in[I_AB_NORM], scr, lane, it0, gw, NGW);
  conv_job<MapId, true>(p.in[I_AB_WOUT], 1024, 1024, (u16*)(ws + WS_WO0T), 1024, nullptr, scr, lane, it0, gw, NGW);
  conv_job<MapCD, true, LayCD>(p.in[I_CD_WIN], 1024, 2744, (u16*)(ws + WS_W1T), CD_N, p.in[I_CD_NORM], scr, lane, it0, gw, NGW);
  conv_job<MapId, true>(p.in[I_CD_WOUT], 1024, 1024, (u16*)(ws + WS_WO1T), 1024, nullptr, scr, lane, it0, gw, NGW);
  conv_job<MapUQ, true, LayUQ>(p.in[I_D_WUQ], 256, 768, (u16*)(ws + WS_WUQT), 768, p.in[I_D_QLN], scr, lane, it0, gw, NGW);
  conv_job<MapUKV, true>(p.in[I_D_WUKV], 128, 1024, (u16*)(ws + WS_WUKVT), 1024, p.in[I_D_KVLN], scr, lane, it0, gw, NGW);
  conv_job<MapId>(p.in[I_C_W1], 2048, 128, (u16*)(ws + WS_WC1T), 128, nullptr, scr, lane, it0, gw, NGW);
  conv_job<MapId>(p.in[I_C_W1] + 2048 * 128, 2048, 128, (u16*)(ws + WS_WC1T) + 128 * 2048, 128, nullptr, scr, lane, it0, gw, NGW);
  conv_job<MapId>(p.in[I_C_W2], 128, 64, (u16*)(ws + WS_WC2T), 64, nullptr, scr, lane, it0, gw, NGW);
  conv_job<MapId>(p.in[I_C_W2] + 128 * 64, 128, 64, (u16*)(ws + WS_WC2T) + 64 * 128, 64, nullptr, scr, lane, it0, gw, NGW);
  {
    const int gt = blockIdx.x * 512 + tid, NGT = gridDim.x * 512;
    f32x2* r64 = (f32x2*)(ws + WS_ROPE64); f32x2* r32 = (f32x2*)(ws + WS_ROPE32);
    for (int e = gt; e < SEQ * 48; e += NGT) {
      const int pos = e / 48, j = e % 48;
      const bool is64 = j < 32; const int i = is64 ? j : j - 32;
      const float ex = is64 ? (float)(2 * i) / 64.f : (float)(2 * i) / 32.f;
      const float inv = exp2f(-ex * 13.287712379549449f);
      const float ang = (float)pos * inv;
      const double rev = (double)ang * 0.15915494309189535; const float fr = (float)(rev - floor(rev));
      f32x2 cs; cs.x = __builtin_amdgcn_cosf(fr); cs.y = __builtin_amdgcn_sinf(fr);
      if (is64) r64[pos * 32 + i] = cs; else r32[pos * 16 + i] = cs;
    }
  }
  if (gw < 256) {
    const int j = gw >> 7, n = gw & 127;
    const float* pe = p.in[I_C_PE] + j * 2048; const float* w1 = p.in[I_C_W1] + (size_t)j * 2048 * 128 + n;
    float s = 0.f;
#pragma unroll 8
    for (int k = lane; k < 2048; k += 64) s += pe[k] * w1[(size_t)k * 128];
    s = wave_sum(s);
    if (lane == 0) ((float*)(ws + WS_CBIAS))[gw] = s;
  }
  {
    const float* x = p.in[I_X]; u16* xb = (u16*)(ws + WS_XB); float* ssq0 = (float*)(ws + WS_SSQ0);
    for (int m0 = gw * 4; m0 < T; m0 += NGW * 4) {
      f32x4 v[4][4]; float s[4];
#pragma unroll
      for (int r = 0; r < 4; ++r) { const f32x4* xr = (const f32x4*)(x + (size_t)(m0 + r) * DM) + lane;
#pragma unroll
        for (int j = 0; j < 4; ++j) v[r][j] = xr[64 * j]; }
#pragma unroll
      for (int r = 0; r < 4; ++r) { s[r] = 0.f;
#pragma unroll
        for (int j = 0; j < 4; ++j) s[r] += v[r][j].x * v[r][j].x + v[r][j].y * v[r][j].y + v[r][j].z * v[r][j].z + v[r][j].w * v[r][j].w; }
#pragma unroll
      for (int o = 1; o < 64; o <<= 1) {
#pragma unroll
        for (int r = 0; r < 4; ++r) s[r] += __shfl_xor(s[r], o); }
#pragma unroll
      for (int r = 0; r < 4; ++r) { u32x2* o = (u32x2*)(xb + (size_t)(m0 + r) * DM) + lane;
#pragma unroll
        for (int j = 0; j < 4; ++j) { u32x2 w; w.x = cvtpk(v[r][j].x, v[r][j].y); w.y = cvtpk(v[r][j].z, v[r][j].w); o[64 * j] = w; }
        if (lane == 0) ssq0[m0 + r] = s[r]; }
    }
  }
}

namespace pg8 {
#define PG8_LAS __attribute__((address_space(3)))
typedef unsigned short bf16_t;
typedef short bf16x8 __attribute__((ext_vector_type(8)));
typedef float f32x4 __attribute__((ext_vector_type(4)));
typedef unsigned u32x4 __attribute__((ext_vector_type(4)));
constexpr int BM = 256, BK = 64, HALF = 128, HTB = HALF * BK * 2  , STAGE_BYTES = 8 * HTB, NXCD = 8, WGM = 8;

__host__ __device__ __forceinline__ int lds_byte(int r, int c) { const int st = (r >> 4) * 2 + (c >> 5), rr = r & 15, cc = c & 31, ob = rr * 64 + cc * 2; return st * 1024 + (ob ^ (((ob >> 9) & 1) << 5)); }
__host__ __device__ __forceinline__ void stage_rc(int b, int& R, int& C) { const int st = b / 1024, sb = b % 1024, swz = sb ^ (((sb >> 9) & 1) << 5); R = (st >> 1) * 16 + swz / 64; C = (st & 1) * 32 + (swz % 64) / 2; }
__host__ __device__ __forceinline__ int perm32(int rho) { const int n = rho >> 4, i = rho & 15; return 8 * (i >> 2) + 4 * n + (i & 3); }

struct Unit { int pm, pn; };
struct Gemm { const bf16_t* A; const bf16_t* Bt; int M, N, K; };

struct StaticOrder {
    int nM, nN, nwg, G, c;
    __host__ __device__ void init(int M, int N, int G_, int c_) { nM = M / BM; nN = N / BM; nwg = nM * nN; G = G_; c = c_; }
    __host__ __device__ bool next(int i, Unit& u) const {
        const long L = (long)i * G + c; if (L >= nwg) return false;
        int wgid = (int)L; { const int q = nwg / NXCD, r = nwg % NXCD, xcd = wgid % NXCD, off = wgid / NXCD; wgid = (xcd < r ? xcd * (q + 1) : r * (q + 1) + (xcd - r) * q) + off; }
        const int nig = WGM * nN, gid = wgid / nig, fm = gid * WGM, gsz = (nM - fm) < WGM ? (nM - fm) : WGM;
        u.pm = fm + ((wgid % nig) % gsz); u.pn = (wgid % nig) / gsz; return true;
    }
    __device__ __forceinline__ void a_ready(const Unit&) const {}
    __device__ __forceinline__ void done(const Unit&) const {}
};


template <class Epi, class Sched, bool ALIGN_EPI = false, bool SP2 = false>
__device__ __forceinline__ void gemm_phase(PG8_LAS unsigned char* lds, const Gemm g, const Sched& S, const Epi& E) {
    const int tid = threadIdx.x, wid = __builtin_amdgcn_readfirstlane(tid >> 6), lane = tid & 63, wr = wid >> 2, wc = wid & 3, fr = lane & 15, fq = lane >> 4;
    const int K = g.K, nt = K / BK;
    unsigned voffA[2], voffB[2];
#pragma unroll
    for (int i = 0; i < 2; ++i) { int R, C; stage_rc(tid * 16 + i * 8192, R, C); const int Rb = Epi::PERM ? ((R & ~31) + perm32(R & 31)) : R;
        voffA[i] = (unsigned)(R * K + C) * 2u; voffB[i] = (unsigned)(Rb * K + C) * 2u; }
    const size_t kstep = (size_t)(BK * 2);
    const size_t hstep = (size_t)HALF * K * 2;
    const size_t tstep = 2 * hstep;
    const unsigned ldsw = (unsigned)wid * 1024u;
    const int aoff = lds_byte(wr * 64 + fr, fq * 8), boff = lds_byte(wc * 32 + fr, fq * 8);
#define PG8_SA(b, h) (((b) * 2 + (h)) * HTB)
#define PG8_SB(b, h) ((4 + (b) * 2 + (h)) * HTB)
#define PG8_STAGE(bufoff, gbase, voff) do { _Pragma("unroll") for (int _i = 0; _i < 2; ++_i) \
        __builtin_amdgcn_global_load_lds((const unsigned*)((const char*)(gbase) + (voff)[_i]), (PG8_LAS unsigned*)(lds + (bufoff) + ldsw + _i * 8192), 16, 0, 0); } while (0)
#define PG8_LDA(dst, b, h) do { _Pragma("unroll") for (int m = 0; m < 4; ++m) _Pragma("unroll") for (int k = 0; k < 2; ++k) dst[m][k] = *(const PG8_LAS bf16x8*)(lds + PG8_SA(b, h) + aoff + m * 2048 + k * 1024); } while (0)
#define PG8_LDB(dst, b, h) do { _Pragma("unroll") for (int n = 0; n < 2; ++n) _Pragma("unroll") for (int k = 0; k < 2; ++k) dst[n][k] = *(const PG8_LAS bf16x8*)(lds + PG8_SB(b, h) + boff + n * 2048 + k * 1024); } while (0)
#define PG8_MMA(ai, bj, At, Bt) do { __builtin_amdgcn_s_setprio(1); _Pragma("unroll") for (int m = 0; m < 4; ++m) _Pragma("unroll") for (int n = 0; n < 2; ++n) _Pragma("unroll") for (int k = 0; k < 2; ++k) \
        acc[ai][bj][m][n] = __builtin_amdgcn_mfma_f32_16x16x32_bf16(Bt[n][k], At[m][k], acc[ai][bj][m][n], 0, 0, 0); __builtin_amdgcn_s_setprio(0); } while (0)
#define PG8_WAIT_V(n) asm volatile("s_waitcnt vmcnt(" #n ")" ::: "memory")
#define PG8_WAIT_L(n) asm volatile("s_waitcnt lgkmcnt(" #n ")" ::: "memory")
#define PG8_BAR __builtin_amdgcn_s_barrier()
#define PG8_SCHED __builtin_amdgcn_sched_barrier(0)
    Unit cur, nxt; int ui = 0;
    if (!S.next(0, cur)) return;
    f32x4 acc[2][2][4][2];
#pragma unroll
    for (int a = 0; a < 2; ++a)
#pragma unroll
        for (int b = 0; b < 2; ++b)
#pragma unroll
            for (int m = 0; m < 4; ++m)
#pragma unroll
                for (int n = 0; n < 2; ++n) acc[a][b][m][n] = (f32x4){0.f, 0.f, 0.f, 0.f};
    bf16x8 At[4][2], B0[2][2], B1[2][2];
    const char* cA = (const char*)g.A + (size_t)cur.pm * tstep; const char* cB = (const char*)g.Bt + (size_t)cur.pn * tstep;
    S.a_ready(cur);
    if constexpr (SP2) {
        PG8_STAGE(PG8_SB(0, 0), cB, voffB); PG8_STAGE(PG8_SB(0, 1), cB + hstep, voffB); PG8_STAGE(PG8_SA(0, 0), cA, voffA); PG8_STAGE(PG8_SA(0, 1), cA + hstep, voffA);
        if (wr == 1) PG8_BAR;
        PG8_WAIT_V(2); PG8_BAR;
        PG8_STAGE(PG8_SB(1, 0), cB + kstep, voffB); PG8_STAGE(PG8_SA(1, 0), cA + kstep, voffA); PG8_STAGE(PG8_SB(1, 1), cB + hstep + kstep, voffB);
        PG8_WAIT_V(6); PG8_BAR;
    } else {
        PG8_STAGE(PG8_SB(0, 0), cB, voffB); PG8_STAGE(PG8_SA(0, 0), cA, voffA); PG8_STAGE(PG8_SB(0, 1), cB + hstep, voffB); PG8_STAGE(PG8_SA(0, 1), cA + hstep, voffA);
        if (wr == 1) PG8_BAR;
        PG8_WAIT_V(4); PG8_BAR;
        PG8_STAGE(PG8_SB(1, 0), cB + kstep, voffB); PG8_STAGE(PG8_SA(1, 0), cA + kstep, voffA); PG8_STAGE(PG8_SB(1, 1), cB + hstep + kstep, voffB);
        PG8_WAIT_V(6); PG8_BAR;
    }
    for (;;) {
        const bool has_next = S.next(ui + 1, nxt);
        const char* nA = has_next ? (const char*)g.A + (size_t)nxt.pm * tstep : cA; const char* nB = has_next ? (const char*)g.Bt + (size_t)nxt.pn * tstep : cB;
        for (int t = 0; t < nt; t += 2) {
            const bool last = (t == nt - 2);
            const char* a1 = cA + (size_t)(t + 1) * kstep;
            const char* a2 = last ? nA : cA + (size_t)(t + 2) * kstep; const char* b2 = last ? nB : cB + (size_t)(t + 2) * kstep;
            const char* a3 = a2 + kstep; const char* b3 = b2 + kstep;
            if (last && has_next) S.a_ready(nxt);
            if constexpr (SP2) {
            PG8_LDB(B0, 0, 0); PG8_LDB(B1, 0, 1); PG8_SCHED; PG8_LDA(At, 0, 0); PG8_STAGE(PG8_SA(1, 1), a1 + hstep, voffA);
            PG8_WAIT_V(8); PG8_WAIT_L(0); PG8_BAR; PG8_MMA(0, 0, At, B0); PG8_MMA(0, 1, At, B1); PG8_BAR; PG8_SCHED;
            PG8_LDA(At, 0, 1); PG8_STAGE(PG8_SB(0, 0), b2, voffB); PG8_STAGE(PG8_SB(0, 1), b2 + hstep, voffB); PG8_STAGE(PG8_SA(0, 0), a2, voffA);
            PG8_WAIT_V(8); PG8_WAIT_L(0); PG8_BAR; PG8_MMA(1, 0, At, B0); PG8_MMA(1, 1, At, B1); PG8_BAR; PG8_SCHED;
            PG8_LDB(B0, 1, 0); PG8_LDB(B1, 1, 1); PG8_SCHED; PG8_LDA(At, 1, 0); PG8_STAGE(PG8_SA(0, 1), a2 + hstep, voffA);
            PG8_WAIT_V(8); PG8_WAIT_L(0); PG8_BAR; PG8_MMA(0, 0, At, B0); PG8_MMA(0, 1, At, B1); PG8_BAR; PG8_SCHED;
            PG8_LDA(At, 1, 1); PG8_STAGE(PG8_SB(1, 0), b3, voffB); PG8_STAGE(PG8_SB(1, 1), b3 + hstep, voffB); PG8_STAGE(PG8_SA(1, 0), a3, voffA);
            PG8_WAIT_V(8); PG8_WAIT_L(0); PG8_BAR; PG8_MMA(1, 0, At, B0); PG8_MMA(1, 1, At, B1); PG8_BAR; PG8_SCHED;
            } else {
            PG8_LDB(B0, 0, 0); PG8_SCHED; PG8_LDA(At, 0, 0); PG8_STAGE(PG8_SA(1, 1), a1 + hstep, voffA);
            PG8_WAIT_L(8); PG8_BAR; PG8_WAIT_L(0); PG8_MMA(0, 0, At, B0); PG8_BAR; PG8_SCHED;
            PG8_LDB(B1, 0, 1); PG8_STAGE(PG8_SB(0, 0), b2, voffB);
            PG8_BAR; PG8_WAIT_L(0); PG8_MMA(0, 1, At, B1); PG8_BAR;
            PG8_LDA(At, 0, 1); PG8_STAGE(PG8_SA(0, 0), a2, voffA);
            PG8_BAR; PG8_WAIT_L(0); PG8_MMA(1, 0, At, B0); PG8_BAR; PG8_SCHED;
            PG8_STAGE(PG8_SB(0, 1), b2 + hstep, voffB);
            PG8_WAIT_V(6); PG8_BAR; PG8_MMA(1, 1, At, B1); PG8_BAR;
            PG8_LDB(B0, 1, 0); PG8_SCHED; PG8_LDA(At, 1, 0); PG8_STAGE(PG8_SA(0, 1), a2 + hstep, voffA);
            PG8_WAIT_L(8); PG8_BAR; PG8_WAIT_L(0); PG8_MMA(0, 0, At, B0); PG8_BAR; PG8_SCHED;
            PG8_LDB(B1, 1, 1); PG8_STAGE(PG8_SB(1, 0), b3, voffB);
            PG8_BAR; PG8_WAIT_L(0); PG8_MMA(0, 1, At, B1); PG8_BAR;
            PG8_LDA(At, 1, 1); PG8_STAGE(PG8_SA(1, 0), a3, voffA);
            PG8_BAR; PG8_WAIT_L(0); PG8_MMA(1, 0, At, B0); PG8_BAR; PG8_SCHED;
            PG8_STAGE(PG8_SB(1, 1), b3 + hstep, voffB);
            PG8_WAIT_V(6); PG8_BAR; PG8_MMA(1, 1, At, B1); PG8_BAR;
            }
        }
        if constexpr (ALIGN_EPI) { if (wr == 0) PG8_BAR; }
        if constexpr (!Epi::AFTER_DRAIN) { E(acc, cur, wr, wc, fr, fq); S.done(cur); }
        if (!has_next) break;
#pragma unroll
        for (int a = 0; a < 2; ++a)
#pragma unroll
            for (int b = 0; b < 2; ++b)
#pragma unroll
                for (int m = 0; m < 4; ++m)
#pragma unroll
                    for (int n = 0; n < 2; ++n) acc[a][b][m][n] = (f32x4){0.f, 0.f, 0.f, 0.f};
        cur = nxt; cA = nA; cB = nB; ++ui;
        if constexpr (ALIGN_EPI) { if (wr == 1) PG8_BAR; }
    }
    PG8_WAIT_V(0);
    if constexpr (!ALIGN_EPI) { if (wr == 0) PG8_BAR; }
    PG8_BAR;
    if constexpr (Epi::AFTER_DRAIN) { E.fused(acc, cur, wr, wc, fr, fq, lds, wid, lane); S.done(cur); }
#undef PG8_SA
#undef PG8_SB
#undef PG8_STAGE
#undef PG8_LDA
#undef PG8_LDB
#undef PG8_MMA
#undef PG8_WAIT_V
#undef PG8_WAIT_L
#undef PG8_BAR
#undef PG8_SCHED
}
}
struct RowVals { float v[4][4]; };

#define COLB(ni, fq) (32 * ((ni) >> 1) + 8 * (fq) + 4 * ((ni) & 1))
__device__ __forceinline__ void ld_gain16(const float* __restrict__ g, int fq, float (&gn)[4][4]) {
#pragma unroll
  for (int ni = 0; ni < 4; ++ni) { const f32x4 t = *(const f32x4*)(g + COLB(ni, fq));
#pragma unroll
    for (int r = 0; r < 4; ++r) gn[ni][r] = t[r]; }
}
__device__ __forceinline__ void rmsnorm64(RowVals& x, const float (&gn)[4][4]) {
  float ss = 0.f;
#pragma unroll
  for (int ni = 0; ni < 4; ++ni)
#pragma unroll
    for (int r = 0; r < 4; ++r) ss += x.v[ni][r] * x.v[ni][r];
  ss = rsum4(ss);
  const float rstd = __builtin_amdgcn_rsqf(ss * (1.f / 64.f) + EPS);
#pragma unroll
  for (int ni = 0; ni < 4; ++ni)
#pragma unroll
    for (int r = 0; r < 4; ++r) x.v[ni][r] *= rstd * gn[ni][r];
}
__device__ __forceinline__ void rope64_apply(RowVals& x, const f32x2* __restrict__ tab_pos, int fq) {
#pragma unroll
  for (int ni = 0; ni < 2; ++ni) {
    const f32x4 t0 = *(const f32x4*)(tab_pos + COLB(ni, fq)), t1 = *(const f32x4*)(tab_pos + COLB(ni, fq) + 2);
    const float cs[4] = {t0.x, t0.z, t1.x, t1.z}, sn[4] = {t0.y, t0.w, t1.y, t1.w};
#pragma unroll
    for (int r = 0; r < 4; ++r) { const float a = x.v[ni][r], b = x.v[ni + 2][r]; x.v[ni][r] = a * cs[r] - b * sn[r]; x.v[ni + 2][r] = b * cs[r] + a * sn[r]; }
  }
}
__device__ __forceinline__ void norm_rope32(RowVals& x, int nA, const float* __restrict__ g32, const f32x2* __restrict__ tab_pos, int fq, float scale) {
  float ss = 0.f;
#pragma unroll
  for (int r = 0; r < 4; ++r) ss += x.v[nA][r] * x.v[nA][r] + x.v[nA + 1][r] * x.v[nA + 1][r];
  ss = rsum4(ss);
  const float rstd = __builtin_amdgcn_rsqf(ss * (1.f / 32.f) + EPS) * scale;
  const f32x4 ga = *(const f32x4*)(g32 + 4 * fq), gb = *(const f32x4*)(g32 + 16 + 4 * fq);
  const f32x4 t0 = *(const f32x4*)(tab_pos + 4 * fq), t1 = *(const f32x4*)(tab_pos + 4 * fq + 2);
  const float cs[4] = {t0.x, t0.z, t1.x, t1.z}, sn[4] = {t0.y, t0.w, t1.y, t1.w};
#pragma unroll
  for (int r = 0; r < 4; ++r) { const float a = x.v[nA][r] * rstd * ga[r], b = x.v[nA + 1][r] * rstd * gb[r]; x.v[nA][r] = a * cs[r] - b * sn[r]; x.v[nA + 1][r] = b * cs[r] + a * sn[r]; }
}
__device__ __forceinline__ void st_bf16_row(u16* dst  , const RowVals& x, int fq, float scale = 1.f) {
#pragma unroll
  for (int bj = 0; bj < 2; ++bj) { u32x4 w; w.x = cvtpk(x.v[2 * bj][0] * scale, x.v[2 * bj][1] * scale); w.y = cvtpk(x.v[2 * bj][2] * scale, x.v[2 * bj][3] * scale);
    w.z = cvtpk(x.v[2 * bj + 1][0] * scale, x.v[2 * bj + 1][1] * scale); w.w = cvtpk(x.v[2 * bj + 1][2] * scale, x.v[2 * bj + 1][3] * scale); *(u32x4*)(dst + 32 * bj + 8 * fq) = w; }
}

__device__ __forceinline__ void st_fp8_row(unsigned char* dst  , const RowVals& x, int fq) {
#pragma unroll
  for (int bj = 0; bj < 2; ++bj) { u32x2 w; int a = 0, b = 0;
    a = __builtin_amdgcn_cvt_pk_fp8_f32(x.v[2 * bj][0], x.v[2 * bj][1], a, false); a = __builtin_amdgcn_cvt_pk_fp8_f32(x.v[2 * bj][2], x.v[2 * bj][3], a, true);
    b = __builtin_amdgcn_cvt_pk_fp8_f32(x.v[2 * bj + 1][0], x.v[2 * bj + 1][1], b, false); b = __builtin_amdgcn_cvt_pk_fp8_f32(x.v[2 * bj + 1][2], x.v[2 * bj + 1][3], b, true);
    w.x = (unsigned)a; w.y = (unsigned)b; *(u32x2*)(dst + 32 * bj + 8 * fq) = w; }
}

template <int LAYER> struct EpiProj {
  unsigned char* ws; const float* const* in;
  __device__ __forceinline__ void operator()(int row0, int g, const f32x4 (&acc)[4][4], int fr, int fq) const {
    const f32x2* rope64 = (const f32x2*)(ws + WS_ROPE64); const f32x2* rope32 = (const f32x2*)(ws + WS_ROPE32);
    int kind; unsigned char* dst8 = nullptr; u16* dst = nullptr; int ld = 0; const float* gain = nullptr; float scale = 1.f; float* fdst = nullptr; float* ssqdst = nullptr; int ssqld = 0;
    if (LAYER == 0) {
      if (g < 8) { kind = 1; dst = (u16*)(ws + L0_QA) + g * 64; ld = 512; gain = in[I_A_QKN]; scale = QS64; }
      else if (g < 10) { kind = 8; dst8 = ws + L0_KVA + (g - 8) * 64; gain = in[I_A_QKN] + 64; }
      else if (g < 12) { kind = 9; dst8 = ws + L0_KVA + (g - 8) * 64; }
      else if (g < 16) { kind = 2; dst = (u16*)(ws + L0_QI) + (g - 12) * 64; ld = 256; }
      else if (g < 17) { kind = 1; dst = (u16*)(ws + L0_KI); ld = 64; gain = in[I_A_KIDXN]; }
      else if (g < 18) { kind = 4; fdst = (float*)(ws + L0_WI); }
      else if (g < 26) { kind = 3; dst = (u16*)(ws + WS_MIX) + (g - 18) * 64; ld = 1024; }
      else if (g < 34) { kind = 1; dst = (u16*)(ws + L0_QB) + (g - 26) * 64; ld = 512; gain = in[I_B_QKN]; scale = QS64; }
      else if (g < 36) { kind = 1; dst = (u16*)(ws + L0_KVB) + (g - 34) * 64; ld = 256; gain = in[I_B_QKN] + 64; }
      else if (g < 38) { kind = 0; dst = (u16*)(ws + L0_KVB) + 128 + (g - 36) * 64; ld = 256; }
      else { kind = 3; dst = (u16*)(ws + WS_MIX) + 512 + (g - 38) * 64; ld = 1024; }
    } else {
      if (g < 8) { kind = 1; dst = (u16*)(ws + L1_QC) + g * 64; ld = 512; gain = in[I_C_QN]; scale = QS64; }
      else if (g < 10) { kind = 0; dst = (u16*)(ws + L1_KCR) + (g - 8) * 64; ld = 128; }
      else if (g < 12) { kind = 0; dst = (u16*)(ws + L1_VCR) + (g - 10) * 64; ld = 128; }
      else if (g < 14) { kind = 1; dst = (u16*)(ws + L1_KVS) + (g - 12) * 64; ld = 256; gain = in[I_C_KN] + 64; }
      else if (g < 16) { kind = 0; dst = (u16*)(ws + L1_KVS) + 128 + (g - 14) * 64; ld = 256; }
      else if (g < 18) { kind = 1; dst = (u16*)(ws + L1_KVW) + (g - 16) * 64; ld = 256; gain = in[I_C_KN] + 128; }
      else if (g < 20) { kind = 0; dst = (u16*)(ws + L1_KVW) + 128 + (g - 18) * 64; ld = 256; }
      else if (g < 21) { kind = 5; fdst = (float*)(ws + L1_GATES); }
      else if (g < 29) { kind = 3; dst = (u16*)(ws + WS_MIX) + (g - 21) * 64; ld = 1024; }
      else if (g < 33) { kind = 6; dst = (u16*)(ws + L1_CQ) + (g - 29) * 64; ld = 256; ssqdst = (float*)(ws + L1_SSQQ) + (g - 29); ssqld = 4; }
      else if (g < 35) { kind = 6; dst = (u16*)(ws + L1_CKV) + (g - 33) * 64; ld = 128; ssqdst = (float*)(ws + L1_SSQKV) + (g - 33); ssqld = 2; }
      else if (g < 36) { kind = 7; dst = (u16*)(ws + L1_KROPE); ld = 32; gain = in[I_D_ROPEN] + 32; }
      else { kind = 3; dst = (u16*)(ws + WS_MIX) + 512 + (g - 36) * 64; ld = 1024; }
    }
    float gn[4][4];
    if (kind == 1 || kind == 8) ld_gain16(gain, fq, gn);
#pragma unroll
    for (int mi = 0; mi < 4; ++mi) {
      const int t = row0 + mi * 16 + fr, pos = t & (SEQ - 1);
      float rstd;
      if (LAYER == 0) rstd = __builtin_amdgcn_rsqf(((const float*)(ws + WS_SSQ0))[t] * (1.f / 1024.f) + EPS);
      else { const f32x4* sp = (const f32x4*)((const float*)(ws + WS_SSQ1P) + (size_t)t * 16); const f32x4 a = sp[0], b = sp[1], c = sp[2], d = sp[3];
             const float s = (a.x + a.y + a.z + a.w) + (b.x + b.y + b.z + b.w) + (c.x + c.y + c.z + c.w) + (d.x + d.y + d.z + d.w); rstd = __builtin_amdgcn_rsqf(s * (1.f / 1024.f) + EPS); }
      RowVals x;
#pragma unroll
      for (int ni = 0; ni < 4; ++ni)
#pragma unroll
        for (int r = 0; r < 4; ++r) x.v[ni][r] = acc[mi][ni][r] * rstd;
      if (kind == 0) { st_bf16_row(dst + (size_t)t * ld, x, fq); }
      else if (LAYER == 0 && kind == 8) { rmsnorm64(x, gn); rope64_apply(x, rope64 + pos * 32, fq); st_fp8_row(dst8 + (size_t)t * 256, x, fq); }
      else if (LAYER == 0 && kind == 9) { st_fp8_row(dst8 + (size_t)t * 256, x, fq); }
      else if (kind == 1) { rmsnorm64(x, gn); rope64_apply(x, rope64 + pos * 32, fq); st_bf16_row(dst + (size_t)t * ld, x, fq, scale); }
      else if (kind == 2) { rope64_apply(x, rope64 + pos * 32, fq); st_bf16_row(dst + (size_t)t * ld, x, fq); }
      else if (kind == 3) {
#pragma unroll
        for (int ni = 0; ni < 4; ++ni)
#pragma unroll
          for (int r = 0; r < 4; ++r) x.v[ni][r] = silu_f(x.v[ni][r]);
        st_bf16_row(dst + (size_t)t * ld, x, fq);
      } else if (kind == 4) { if (fq == 0) *(f32x4*)(fdst + (size_t)t * 4) = (f32x4){x.v[0][0], x.v[0][1], x.v[0][2], x.v[0][3]}; }
      else if (kind == 5) {
        if (fq < 3) {
          *(f32x4*)(fdst + (size_t)t * 24 + 8 * fq) = (f32x4){sigmoid_f(x.v[0][0]), sigmoid_f(x.v[0][1]), sigmoid_f(x.v[0][2]), sigmoid_f(x.v[0][3])};
          *(f32x4*)(fdst + (size_t)t * 24 + 8 * fq + 4) = (f32x4){sigmoid_f(x.v[1][0]), sigmoid_f(x.v[1][1]), sigmoid_f(x.v[1][2]), sigmoid_f(x.v[1][3])};
        }
      } else if (kind == 6) {
        float ss = 0.f;
#pragma unroll
        for (int ni = 0; ni < 4; ++ni)
#pragma unroll
          for (int r = 0; r < 4; ++r) ss += x.v[ni][r] * x.v[ni][r];
        ss = rsum4(ss);
        if (fq == 0) ssqdst[(size_t)t * ssqld] = ss;
        st_bf16_row(dst + (size_t)t * ld, x, fq);
      } else {
        norm_rope32(x, 0, gain, rope32 + pos * 16, fq, 1.f);
        u32x2 w0, w1; w0.x = cvtpk(x.v[0][0], x.v[0][1]); w0.y = cvtpk(x.v[0][2], x.v[0][3]); w1.x = cvtpk(x.v[1][0], x.v[1][1]); w1.y = cvtpk(x.v[1][2], x.v[1][3]);
        *(u32x2*)(dst + (size_t)t * 32 + 4 * fq) = w0; *(u32x2*)(dst + (size_t)t * 32 + 16 + 4 * fq) = w1;
      }
    }
  }
};

template <int WHICH> struct EpiUp {
  unsigned char* ws; const float* const* in;
  __device__ __forceinline__ void operator()(int row0, int g, const f32x4 (&acc)[4][4], int fr, int fq) const {
    const f32x2* rope32 = (const f32x2*)(ws + WS_ROPE32);
    const bool nope = g < 8;
#pragma unroll
    for (int mi = 0; mi < 4; ++mi) {
      const int t = row0 + mi * 16 + fr, pos = t & (SEQ - 1);
      float gn[4][4];
      if (nope) ld_gain16(in[I_D_NOPEN] + (WHICH == 0 ? 0 : 64), fq, gn);
      asm volatile("" ::: "memory");
      float rstd;
      if (WHICH == 0) { const f32x4 s = *(const f32x4*)((const float*)(ws + L1_SSQQ) + (size_t)t * 4); rstd = __builtin_amdgcn_rsqf((s.x + s.y + s.z + s.w) * (1.f / 256.f) + EPS); }
      else { const f32x2 s = *(const f32x2*)((const float*)(ws + L1_SSQKV) + (size_t)t * 2); rstd = __builtin_amdgcn_rsqf((s.x + s.y) * (1.f / 128.f) + EPS); }
      RowVals x;
#pragma unroll
      for (int ni = 0; ni < 4; ++ni)
#pragma unroll
        for (int r = 0; r < 4; ++r) x.v[ni][r] = acc[mi][ni][r] * rstd;
      if (WHICH == 0) {
        u16* qm = (u16*)(ws + L1_QM) + (size_t)t * 768;
        if (nope) { rmsnorm64(x, gn); st_bf16_row(qm + g * 96, x, fq, QS96); }
        else {
#pragma unroll
          for (int hh = 0; hh < 2; ++hh) {
            norm_rope32(x, 2 * hh, in[I_D_ROPEN], rope32 + pos * 16, fq, QS96);
            u16* d = qm + (2 * (g - 8) + hh) * 96 + 64;
            u32x2 w0, w1; w0.x = cvtpk(x.v[2 * hh][0], x.v[2 * hh][1]); w0.y = cvtpk(x.v[2 * hh][2], x.v[2 * hh][3]);
            w1.x = cvtpk(x.v[2 * hh + 1][0], x.v[2 * hh + 1][1]); w1.y = cvtpk(x.v[2 * hh + 1][2], x.v[2 * hh + 1][3]);
            *(u32x2*)(d + 4 * fq) = w0; *(u32x2*)(d + 16 + 4 * fq) = w1;
          }
        }
      } else {
        if (nope) { rmsnorm64(x, gn); st_bf16_row((u16*)(ws + L1_KN) + (size_t)t * 512 + g * 64, x, fq); }
        else st_bf16_row((u16*)(ws + L1_VM) + (size_t)t * 512 + (g - 8) * 64, x, fq);
      }
    }
  }
};

template <int LAYER> struct EpiOut {
  unsigned char* ws; const float* x; float* out;
  __device__ __forceinline__ void operator()(int row0, int g, const f32x4 (&acc)[4][4], int fr, int fq) const {
    u16* xb1 = (u16*)(ws + WS_XB);
#pragma unroll
    for (int mp = 0; mp < 2; ++mp) {
      f32x4 bv[2][4];
#pragma unroll
      for (int mm = 0; mm < 2; ++mm) { const int t = row0 + (2 * mp + mm) * 16 + fr; const size_t off = (size_t)t * DM + g * 64;
        if (LAYER == 0) {
#pragma unroll
          for (int ni = 0; ni < 4; ++ni) bv[mm][ni] = *(const f32x4*)(x + off + COLB(ni, fq));
        } else {
#pragma unroll
          for (int bj = 0; bj < 2; ++bj) { const u32x4 w = *(const u32x4*)(xb1 + off + 32 * bj + 8 * fq);
            bv[mm][2 * bj] = (f32x4){__uint_as_float(w.x << 16), __uint_as_float(w.x & 0xffff0000u), __uint_as_float(w.y << 16), __uint_as_float(w.y & 0xffff0000u)};
            bv[mm][2 * bj + 1] = (f32x4){__uint_as_float(w.z << 16), __uint_as_float(w.z & 0xffff0000u), __uint_as_float(w.w << 16), __uint_as_float(w.w & 0xffff0000u)}; }
        } }
#pragma unroll
      for (int mm = 0; mm < 2; ++mm) {
        const int mi = 2 * mp + mm, t = row0 + mi * 16 + fr; const size_t off = (size_t)t * DM + g * 64;
        float ss = 0.f;
#pragma unroll
        for (int ni = 0; ni < 4; ++ni) {
          const int cb = COLB(ni, fq);
          const f32x4 o = bv[mm][ni] + acc[mi][ni];
          if (LAYER == 0) {
            ss += o.x * o.x + o.y * o.y + o.z * o.z + o.w * o.w;
            u32x2 w; w.x = cvtpk(o.x, o.y); w.y = cvtpk(o.z, o.w); *(u32x2*)(xb1 + off + cb) = w;
          } else *(f32x4*)(out + off + cb) = o;
        }
        if (LAYER == 0) { ss = rsum4(ss); if (fq == 0) ((float*)(ws + WS_SSQ1P))[(size_t)t * 16 + g] = ss; }
      }
    }
  }
};

struct EpiNull {
  float* sink;
  __device__ __forceinline__ void operator()(int row0, int g, const f32x4 (&acc)[4][4], int fr, int fq) const {
    float s = 0.f;
#pragma unroll
    for (int mi = 0; mi < 4; ++mi)
#pragma unroll
      for (int ni = 0; ni < 4; ++ni) s += acc[mi][ni][0] + acc[mi][ni][1] + acc[mi][ni][2] + acc[mi][ni][3];
    if (s == 123.456f) sink[row0 + fr] = s;
  }
};
template <class E> struct Pg8Epi {
  static constexpr bool PERM = false, AFTER_DRAIN = false;
  E e; int ngroups;
  __device__ __forceinline__ void operator()(const f32x4 (&acc)[2][2][4][2], const pg8::Unit& u, int wr, int wc, int fr, int fq) const {
    const int g = u.pn * 4 + wc;
    if (g >= ngroups) return;
#pragma unroll
    for (int ai = 0; ai < 2; ++ai) {
      f32x4 a4[4][4];
#pragma unroll
      for (int m = 0; m < 4; ++m)
#pragma unroll
        for (int ni = 0; ni < 4; ++ni) a4[m][ni] = acc[ai][ni >> 1][m][ni & 1];
      e(u.pm * 256 + ai * 128 + wr * 64, g, a4, fr, fq);
    }
  }
};
template <class E> __device__ __forceinline__ void run_gemm(char* lds, const u16* A, const u16* Bt, int M, int N, int K, const E& e, int ngroups) {
  asm volatile("" : "+s"(K));
  pg8::Gemm g{A, Bt, M, N, K}; pg8::StaticOrder S; S.init(M, N, (int)gridDim.x, (int)blockIdx.x);
  Pg8Epi<E> pe{e, ngroups};
  pg8::gemm_phase<Pg8Epi<E>, pg8::StaticOrder, true, true>((PG8_LAS unsigned char*)lds, g, S, pe);
}
constexpr int CH_K = 0, CH_V = 8192, CH_R = 16384, CH_BYTES = 16384, CH_BYTES_ROPE = 24576;

__device__ __forceinline__ unsigned kimg_off(int key, int c) { return (unsigned)(key * 128 + ((c ^ ((key >> 1) & 7)) << 4)); }
__device__ __forceinline__ unsigned vimg_off(int key, int c) { return (unsigned)(key * 128 + ((((c >> 1) ^ ((key >> 1) & 3)) << 5) | ((c & 1) << 4))); }
__device__ __forceinline__ unsigned vimg32_off(int key, int c) { return (unsigned)(key * 128 + ((((c >> 1) ^ (((key >> 1) & 1) << 1)) << 5) | ((c & 1) << 4))); }

struct ChunkRegs { u32x4 k, v, r; };
template <bool ROPE>
__device__ __forceinline__ void chunk_fetch(ChunkRegs& cr, const u16* __restrict__ Kg, int ldk, const u16* __restrict__ Vg, int ldv, const u16* __restrict__ Rg, int k0, int kmax  , int tid) {
  asm volatile("" : "+v"(tid));
  int key = k0 + (tid >> 3); if (key > kmax) key = kmax;
  cr.k = *(const u32x4*)(Kg + (size_t)key * ldk + (tid & 7) * 8);
  cr.v = *(const u32x4*)(Vg + (size_t)key * ldv + (tid & 7) * 8);
  if (ROPE) { if (tid < 256) { int kr = k0 + (tid >> 2); if (kr > kmax) kr = kmax; cr.r = *(const u32x4*)(Rg + (size_t)kr * 32 + (tid & 3) * 8); } }
}
template <bool ROPE, bool V32 = false>
__device__ __forceinline__ void chunk_store(const ChunkRegs& cr, char* buf, int tid) {
  asm volatile("" : "+v"(tid));
  const int key = tid >> 3, c = tid & 7;
  *(u32x4*)(buf + CH_K + kimg_off(key, c)) = cr.k;
  *(u32x4*)(buf + CH_V + (V32 ? vimg32_off(key, c) : vimg_off(key, c))) = cr.v;
  if (ROPE) { if (tid < 256) *(u32x4*)(buf + CH_R + kimg_off(tid >> 2, tid & 3)) = cr.r; }
}

constexpr float ATTN_THR = 8.f;
template <int NT> struct AttnAcc { f32x4 o[NT][4]; f32x4 lv[NT]; f32x4 nsh[NT]; float m[NT], l[NT]; };
template <int NT> __device__ __forceinline__ void acc_init(AttnAcc<NT>& st, float m0, float l0) {
#pragma unroll
  for (int nt = 0; nt < NT; ++nt) { st.m[nt] = m0; st.l[nt] = l0; st.lv[nt] = (f32x4){0.f, 0.f, 0.f, 0.f}; st.nsh[nt] = (f32x4){-m0, -m0, -m0, -m0};
#pragma unroll
    for (int dt = 0; dt < 4; ++dt) st.o[nt][dt] = (f32x4){0.f, 0.f, 0.f, 0.f}; }
}
__device__ __forceinline__ v4i16_t tr_read(const char* p) { return __builtin_amdgcn_ds_read_tr16_b64_v4i16((LAS v4i16_t*)(uintptr_t)(unsigned)(uintptr_t)p); }

__device__ __forceinline__ float max3f(float a, float b, float c) { float r; asm("v_max3_f32 %0, %1, %2, %3" : "=v"(r) : "v"(a), "v"(b), "v"(c)); return r; }
__device__ __forceinline__ float max2f(float a, float b) { float r; asm("v_max_f32_e32 %0, %1, %2" : "=v"(r) : "v"(a), "v"(b)); return r; }
template <int KS, int NT, int TM, int NSTEP, int ABL = 0, bool RM = false>
__device__ __forceinline__ void attn_steps(const char* img0, const char* img1, const bf16x8 (&qf)[NT][KS], AttnAcc<NT>& st, bool need_mask, const int (&lo)[NT], const int (&hi)[NT], const int (&hi2)[NT]  , int kbase, int lane) {
  f32x4 cin[2][NT];
#pragma unroll
  for (int nt = 0; nt < NT; ++nt) {
    if (RM) { const f32x4 ninf = {-INFINITY, -INFINITY, -INFINITY, -INFINITY}; cin[0][nt] = hi[nt] < 0 ? ninf : st.nsh[nt]; cin[1][nt] = hi2[nt] < 0 ? ninf : st.nsh[nt]; }
    else { cin[0][nt] = st.nsh[nt]; cin[1][nt] = st.nsh[nt]; }
  }
  asm volatile("" : "+v"(lane));
  const int fr = lane & 15, fq = lane >> 4;
  const int ksw = (fr >> 1) & 7;
  const unsigned krow = (unsigned)(fr * 128);
  const int q = fr >> 2, pp = lane & 3;
  const int vkey = 4 * fq + q;
  const int vsw = (vkey >> 1) & 3;
  bf16x8 ka[2][2][KS]; f32x4 sc[2][NT][2]; v4i16_t vl[4], vh[4];
#define AS_IMG(s_) (((s_) < 2) ? img0 : img1)
#define AS_LDK(s_) do { const char* im_ = AS_IMG(s_); _Pragma("unroll") for (int kt = 0; kt < 2; ++kt) { const unsigned ro_ = (unsigned)((32 * ((s_) & 1) + 16 * kt) * 128) + krow; \
      _Pragma("unroll") for (int kk = 0; kk < KS; ++kk) { \
        if (ABL & 8) ka[(s_) & 1][kt][kk] = qf[0][kk]; \
        else if (kk < 2) ka[(s_) & 1][kt][kk] = *(const bf16x8*)(im_ + CH_K + ro_ + (((fq + 4 * kk) ^ ksw) << 4)); \
        else ka[(s_) & 1][kt][kk] = *(const bf16x8*)(im_ + CH_R + ro_ + ((fq ^ ksw) << 4)); } } } while (0)
#define AS_LDV(s_) do { const char* im_ = AS_IMG(s_); _Pragma("unroll") for (int dt = 0; dt < 4; ++dt) { const char* vb_ = im_ + CH_V + (32 * ((s_) & 1) + vkey) * 128 + ((dt ^ vsw) << 5) + pp * 8; \
      if (ABL & 8) { vl[dt] = (v4i16_t){1, 2, 3, 4}; vh[dt] = vl[dt]; } else { vl[dt] = tr_read(vb_); vh[dt] = tr_read(vb_ + 16 * 128); } } } while (0)
#define AS_QK(s_) do { _Pragma("unroll") for (int kt = 0; kt < 2; ++kt) _Pragma("unroll") for (int kk = 0; kk < KS; ++kk) _Pragma("unroll") for (int nt = 0; nt < NT; ++nt) if (TM & (1 << nt)) \
        sc[(s_) & 1][nt][kt] = MFMA16(ka[(s_) & 1][kt][kk], qf[nt][kk], kk == 0 ? cin[(s_) >> 1][nt] : sc[(s_) & 1][nt][kt]); } while (0)
  AS_LDK(0);
  if (NSTEP > 1) AS_LDK(1);
  AS_QK(0);
#pragma unroll
  for (int s = 0; s < NSTEP; ++s) {
    const int c = s & 1;
    AS_LDV(s);
    if (s + 2 < NSTEP) AS_LDK(s + 2);
#pragma unroll
    for (int nt = 0; nt < NT; ++nt) {
      if (!(TM & (1 << nt))) continue;
      if (need_mask) {
#pragma unroll
        for (int kt = 0; kt < 2; ++kt)
#pragma unroll
          for (int r = 0; r < 4; ++r) { const int key = kbase + 32 * s + 16 * kt + 4 * fq + r; if (key < lo[nt] || key > (s < 2 ? hi[nt] : hi2[nt])) sc[c][nt][kt][r] = -INFINITY; }
      }
    }
    if (s + 1 < NSTEP) AS_QK(s + 1);
    bf16x8 pb[NT];
#pragma unroll
    for (int nt = 0; nt < NT; ++nt) {
      if (!(TM & (1 << nt))) continue;
      float p[2][4];
#pragma unroll
      for (int kt = 0; kt < 2; ++kt)
#pragma unroll
        for (int r = 0; r < 4; ++r) p[kt][r] = (ABL & 2) ? sc[c][nt][kt][r] : __builtin_amdgcn_exp2f(sc[c][nt][kt][r]);
      u32x4 w; w.x = cvtpk(p[0][0], p[0][1]); w.y = cvtpk(p[0][2], p[0][3]); w.z = cvtpk(p[1][0], p[1][1]); w.w = cvtpk(p[1][2], p[1][3]);
      pb[nt] = __builtin_bit_cast(bf16x8, w);
    }
    { const bf16x8 ones = {0x3F80, 0x3F80, 0x3F80, 0x3F80, 0x3F80, 0x3F80, 0x3F80, 0x3F80};
#pragma unroll
      for (int nt = 0; nt < NT; ++nt) if (TM & (1 << nt)) st.lv[nt] = MFMA16(ones, pb[nt], st.lv[nt]); }
#pragma unroll
    for (int dt = 0; dt < 4; ++dt) {
      const bf16x8 a = (bf16x8){vl[dt][0], vl[dt][1], vl[dt][2], vl[dt][3], vh[dt][0], vh[dt][1], vh[dt][2], vh[dt][3]};
#pragma unroll
      for (int nt = 0; nt < NT; ++nt) if (!(ABL & 1) && (TM & (1 << nt))) st.o[nt][dt] = MFMA16(a, pb[nt], st.o[nt][dt]);
      if (ABL & 1) { asm volatile("" :: "v"(a)); _Pragma("unroll") for (int nt = 0; nt < NT; ++nt) asm volatile("" :: "v"(pb[nt])); }
    }
  }
#undef AS_IMG
#undef AS_LDK
#undef AS_LDV
#undef AS_QK
}
template <int NT>
__device__ __forceinline__ void attn_probs(const char* buf, const bf16x8 (&qf)[NT][2], const float (&mfin)[NT], const float (&linv)[NT], const int (&hi)[NT], int kbase, int lane, float (&pr)[NT][4][4]) {
  const int fr = lane & 15, fq = lane >> 4; const int ksw = (fr >> 1) & 7;
#pragma unroll
  for (int kt4 = 0; kt4 < 4; ++kt4) {
    f32x4 sc[NT];
#pragma unroll
    for (int nt = 0; nt < NT; ++nt) sc[nt] = (f32x4){0.f, 0.f, 0.f, 0.f};
#pragma unroll
    for (int kk = 0; kk < 2; ++kk) {
      const bf16x8 a = *(const bf16x8*)(buf + CH_K + (16 * kt4 + fr) * 128 + (((fq + 4 * kk) ^ ksw) << 4));
#pragma unroll
      for (int nt = 0; nt < NT; ++nt) sc[nt] = MFMA16(a, qf[nt][kk], sc[nt]);
    }
#pragma unroll
    for (int nt = 0; nt < NT; ++nt)
#pragma unroll
      for (int r = 0; r < 4; ++r) { const int key = kbase + 16 * kt4 + 4 * fq + r; pr[nt][kt4][r] = (key <= hi[nt]) ? __builtin_amdgcn_exp2f(sc[nt][r] - mfin[nt]) * linv[nt] : 0.f; }
  }
}

template <int KS, int NT, bool ROPE, int ABL = 0>
__device__ __forceinline__ void attn_run(char* lds, const u16* Kg, int ldk, const u16* Vg, int ldv, const u16* Rg, int kfirst, int klast, int kmaxrow,
                                         const bf16x8 (&qf)[NT][KS], AttnAcc<NT>& st, const int (&lo)[NT], const int (&hi)[NT], int wlo, int whi, int tid, int lane) {
  ChunkRegs crA, crB;
  if (kfirst <= klast) {
    chunk_fetch<ROPE>(crA, Kg, ldk, Vg, ldv, Rg, kfirst, kmaxrow, tid);
    chunk_fetch<ROPE>(crB, Kg, ldk, Vg, ldv, Rg, kfirst + 64, kmaxrow, tid);
    int it = 0;
    for (int kb = kfirst; kb <= klast; kb += 128, it ^= 1) {
      constexpr int IMG = ROPE ? CH_BYTES_ROPE : CH_BYTES;
      char* bufA = lds + (2 * it) * IMG; char* bufB = bufA + IMG;
      chunk_store<ROPE>(crA, bufA, tid);
      chunk_store<ROPE>(crB, bufB, tid);
      __syncthreads();
      chunk_fetch<ROPE>(crA, Kg, ldk, Vg, ldv, Rg, kb + 128, kmaxrow, tid);
      chunk_fetch<ROPE>(crB, Kg, ldk, Vg, ldv, Rg, kb + 192, kmaxrow, tid);
      if (kb + 127 >= wlo && kb <= whi) {
        bool nm = false;
#pragma unroll
        for (int nt = 0; nt < NT; ++nt) nm |= (lo[nt] > kb) || (hi[nt] < kb + 127);
        nm = __any(nm);
        attn_steps<KS, NT, (1 << NT) - 1, 4, ABL>(bufA, bufB, qf, st, nm, lo, hi, hi, kb, lane);
      }
    }
  }
  __syncthreads();
}

template <int KS> __device__ __forceinline__ float qrow_norm(const bf16x8 (&q)[KS]) {
  float ss = 0.f;
#pragma unroll
  for (int kk = 0; kk < KS; ++kk)
#pragma unroll
    for (int j = 0; j < 8; ++j) { const float a = bf1((u16)q[kk][j]); ss += a * a; }
  return __builtin_sqrtf(rsum4(ss));
}
template <int NT> __device__ __forceinline__ void acc_start(AttnAcc<NT>& st, const float (&shift)[NT]) {
#pragma unroll
  for (int nt = 0; nt < NT; ++nt) { st.m[nt] = shift[nt]; st.l[nt] = 0.f; st.lv[nt] = (f32x4){0.f, 0.f, 0.f, 0.f}; st.nsh[nt] = (f32x4){-shift[nt], -shift[nt], -shift[nt], -shift[nt]};
#pragma unroll
    for (int dt = 0; dt < 4; ++dt) st.o[nt][dt] = (f32x4){0.f, 0.f, 0.f, 0.f}; }
}
__device__ __forceinline__ float wave_maxf(float v) {
#pragma unroll
  for (int o = 1; o < 64; o <<= 1) v = fmaxf(v, __shfl_xor(v, o));
  return v;
}
template <int NT> __device__ __forceinline__ void attn_finish(AttnAcc<NT>& st) {
#pragma unroll
  for (int nt = 0; nt < NT; ++nt) {
    const float lt = st.lv[nt][0] + st.l[nt];
    const float inv = lt > 0.f ? __builtin_amdgcn_rcpf(lt) : 0.f;
    st.l[nt] = lt;
#pragma unroll
    for (int dt = 0; dt < 4; ++dt) st.o[nt][dt] *= inv;
  }
}
__device__ __forceinline__ void gated_store(u16* mixrow, const f32x4 (&o)[4], int fq) {
#pragma unroll
  for (int dt = 0; dt < 4; ++dt) {
    u32x2* p = (u32x2*)(mixrow + 16 * dt + 4 * fq); const u32x2 z = *p;
    u32x2 w; w.x = cvtpk(o[dt][0] * bflo(z.x), o[dt][1] * bfhi(z.x)); w.y = cvtpk(o[dt][2] * bflo(z.y), o[dt][3] * bfhi(z.y)); *p = w;
  }
}

typedef float f32x16 __attribute__((ext_vector_type(16)));
#define MFMA32(a, b, c) __builtin_amdgcn_mfma_f32_32x32x16_bf16((a), (b), (c), 0, 0, 0)
struct Acc32 { f32x16 o[2]; f32x16 nsh; float m, lsum, lx; };
__device__ __forceinline__ void acc32_start(Acc32& st, float shift) {
  st.m = shift; st.lsum = 0.f; st.lx = 0.f;
#pragma unroll
  for (int r = 0; r < 16; ++r) { st.nsh[r] = -shift; st.o[0][r] = 0.f; st.o[1][r] = 0.f; }
}
template <int KS> __device__ __forceinline__ float qrow_norm32(const bf16x8 (&q)[KS]) {
  float ss = 0.f;
#pragma unroll
  for (int kk = 0; kk < KS; ++kk)
#pragma unroll
    for (int j = 0; j < 8; ++j) { const float a = bf1((u16)q[kk][j]); ss += a * a; }
  auto b = __builtin_amdgcn_permlane32_swap(__float_as_uint(ss), __float_as_uint(ss), false, false);
  return __builtin_sqrtf(__uint_as_float(b[0]) + __uint_as_float(b[1]));
}
template <int KS, int NSTEP, int ABL = 0>
__device__ __forceinline__ void attn_steps32(const char* img0, const char* img1, const bf16x8 (&qf)[KS], Acc32& st, bool need_mask, int lo, int hi, int kbase, int lane) {
  asm volatile("" : "+v"(lane));
  const int l31 = lane & 31, hh = lane >> 5;
  const int ksw = (l31 >> 1) & 7;
  const unsigned krow = (unsigned)(l31 * 128);
  const int q = (lane & 15) >> 2, pp = lane & 3, g16 = (lane >> 4) & 1;
  const int vrow = 4 * hh + q;
  const int vsw = ((q >> 1) & 1) << 1;
  bf16x8 ka[2][KS]; f32x16 sc[2]; v4i16_t vf[2][2][2];
#define A3_IMG(s_) (((s_) < 2) ? img0 : img1)
#define A3_LDK(s_) do { const char* im_ = A3_IMG(s_); const unsigned ro_ = (unsigned)(32 * ((s_) & 1) * 128) + krow; \
      _Pragma("unroll") for (int kk = 0; kk < KS; ++kk) { \
        if (ABL & 8) ka[(s_) & 1][kk] = qf[kk]; \
        else if (kk < 4) ka[(s_) & 1][kk] = *(const bf16x8*)(im_ + CH_K + ro_ + (((hh + 2 * kk) ^ ksw) << 4)); \
        else ka[(s_) & 1][kk] = *(const bf16x8*)(im_ + CH_R + ro_ + (((hh + 2 * (kk - 4)) ^ ksw) << 4)); } } while (0)
#define A3_LDV(s_) do { const char* im_ = A3_IMG(s_); _Pragma("unroll") for (int ks = 0; ks < 2; ++ks) _Pragma("unroll") for (int db = 0; db < 2; ++db) { \
      const char* vb_ = im_ + CH_V + (32 * ((s_) & 1) + 16 * ks + vrow) * 128 + (((2 * db + g16) ^ vsw) << 5) + pp * 8; \
      if (ABL & 8) { vf[ks][db][0] = (v4i16_t){1, 2, 3, 4}; vf[ks][db][1] = vf[ks][db][0]; } else { vf[ks][db][0] = tr_read(vb_); vf[ks][db][1] = tr_read(vb_ + 8 * 128); } } } while (0)
#define A3_QK(s_) do { _Pragma("unroll") for (int kk = 0; kk < KS; ++kk) sc[(s_) & 1] = MFMA32(ka[(s_) & 1][kk], qf[kk], kk == 0 ? st.nsh : sc[(s_) & 1]); } while (0)
  A3_LDK(0);
  if (NSTEP > 1) A3_LDK(1);
  A3_QK(0);
#pragma unroll
  for (int s = 0; s < NSTEP; ++s) {
    const int c = s & 1;
    A3_LDV(s);
    if (s + 2 < NSTEP) A3_LDK(s + 2);
    if (need_mask) {
#pragma unroll
      for (int r = 0; r < 16; ++r) { const int key = kbase + 32 * s + (r & 3) + 8 * (r >> 2) + 4 * hh; if (key < lo || key > hi) sc[c][r] = -INFINITY; }
    }
    if (s + 1 < NSTEP) A3_QK(s + 1);
    float p[16]; float ps = 0.f;
#pragma unroll
    for (int r = 0; r < 16; ++r) { p[r] = (ABL & 2) ? sc[c][r] : __builtin_amdgcn_exp2f(sc[c][r]); ps += p[r]; }
    st.lsum += ps;
#pragma unroll
    for (int ks = 0; ks < 2; ++ks) {
      u32x4 w; w.x = cvtpk(p[8 * ks], p[8 * ks + 1]); w.y = cvtpk(p[8 * ks + 2], p[8 * ks + 3]); w.z = cvtpk(p[8 * ks + 4], p[8 * ks + 5]); w.w = cvtpk(p[8 * ks + 6], p[8 * ks + 7]);
      const bf16x8 pb = __builtin_bit_cast(bf16x8, w);
#pragma unroll
      for (int db = 0; db < 2; ++db) {
        const bf16x8 a = (bf16x8){vf[ks][db][0][0], vf[ks][db][0][1], vf[ks][db][0][2], vf[ks][db][0][3], vf[ks][db][1][0], vf[ks][db][1][1], vf[ks][db][1][2], vf[ks][db][1][3]};
        if (!(ABL & 1)) st.o[db] = MFMA32(a, pb, st.o[db]); else { asm volatile("" :: "v"(a)); asm volatile("" :: "v"(pb)); }
      }
    }
  }
#undef A3_IMG
#undef A3_LDK
#undef A3_LDV
#undef A3_QK
}
template <int KS, bool ROPE, int ABL = 0>
__device__ __forceinline__ void attn_run32(char* lds, const u16* Kg, int ldk, const u16* Vg, int ldv, const u16* Rg, int kfirst, int klast, int kmaxrow,
                                           const bf16x8 (&qf)[KS], Acc32& st, int lo, int hi, int wlo, int whi, int tid, int lane) {
  ChunkRegs crA, crB;
  if (kfirst <= klast) {
    chunk_fetch<ROPE>(crA, Kg, ldk, Vg, ldv, Rg, kfirst, kmaxrow, tid);
    chunk_fetch<ROPE>(crB, Kg, ldk, Vg, ldv, Rg, kfirst + 64, kmaxrow, tid);
    int it = 0;
    for (int kb = kfirst; kb <= klast; kb += 128, it ^= 1) {
      constexpr int IMG = ROPE ? CH_BYTES_ROPE : CH_BYTES;
      char* bufA = lds + (2 * it) * IMG; char* bufB = bufA + IMG;
      chunk_store<ROPE, true>(crA, bufA, tid);
      chunk_store<ROPE, true>(crB, bufB, tid);
      __syncthreads();
      chunk_fetch<ROPE>(crA, Kg, ldk, Vg, ldv, Rg, kb + 128, kmaxrow, tid);
      chunk_fetch<ROPE>(crB, Kg, ldk, Vg, ldv, Rg, kb + 192, kmaxrow, tid);
      if (kb + 127 >= wlo && kb <= whi) {
        const bool nm = __any((lo > kb) || (hi < kb + 127));
        attn_steps32<KS, 4, ABL>(bufA, bufB, qf, st, nm, lo, hi, kb, lane);
      }
    }
  }
  __syncthreads();
}
struct Acc32x2 { f32x16 o[2][2]; float m[2], lsum[2]; };
template <int KS, int NSTEP>
__device__ __forceinline__ void attn_steps32x2(const char* img0, const char* img1, const bf16x8 (&qf)[2][KS], Acc32x2& st, bool need_mask, const int (&hi)[2], int kbase, int lane) {
  asm volatile("" : "+v"(lane));
  const int l31 = lane & 31, hh = lane >> 5;
  const int ksw = (l31 >> 1) & 7;
  const unsigned krow = (unsigned)(l31 * 128);
  const int q = (lane & 15) >> 2, pp = lane & 3, g16 = (lane >> 4) & 1;
  const int vrow = 4 * hh + q;
  const int vsw = ((q >> 1) & 1) << 1;
  const f32x16 Z = {0.f, 0.f, 0.f, 0.f, 0.f, 0.f, 0.f, 0.f, 0.f, 0.f, 0.f, 0.f, 0.f, 0.f, 0.f, 0.f};
#pragma unroll 1
  for (int s = 0; s < NSTEP; ++s) {
    const char* im = (s < 2) ? img0 : img1;
    bf16x8 ka[KS]; v4i16_t vf[2][2][2];
    { const unsigned ro = (unsigned)(32 * (s & 1) * 128) + krow;
#pragma unroll
      for (int kk = 0; kk < KS; ++kk) {
        if (kk < 4) ka[kk] = *(const bf16x8*)(im + CH_K + ro + (((hh + 2 * kk) ^ ksw) << 4));
        else ka[kk] = *(const bf16x8*)(im + CH_R + ro + (((hh + 2 * (kk - 4)) ^ ksw) << 4));
      } }
#pragma unroll
    for (int ks = 0; ks < 2; ++ks)
#pragma unroll
      for (int db = 0; db < 2; ++db) {
        const char* vb = im + CH_V + (32 * (s & 1) + 16 * ks + vrow) * 128 + (((2 * db + g16) ^ vsw) << 5) + pp * 8;
        vf[ks][db][0] = tr_read(vb); vf[ks][db][1] = tr_read(vb + 8 * 128);
      }
    __builtin_amdgcn_sched_barrier(0);
    f32x16 sc[2];
#pragma unroll
    for (int kk = 0; kk < KS; ++kk)
#pragma unroll
      for (int t = 0; t < 2; ++t) sc[t] = MFMA32(ka[kk], qf[t][kk], kk == 0 ? Z : sc[t]);
    bf16x8 pb[2][2];
#pragma unroll
    for (int t = 0; t < 2; ++t) {
      if (need_mask) {
#pragma unroll
        for (int r = 0; r < 16; ++r) { const int key = kbase + 32 * s + (r & 3) + 8 * (r >> 2) + 4 * hh; if (key > hi[t]) sc[t][r] = -INFINITY; }
      }
      float p[16]; float ps = 0.f;
#pragma unroll
      for (int r = 0; r < 16; ++r) { p[r] = __builtin_amdgcn_exp2f(sc[t][r] - st.m[t]); ps += p[r]; }
      st.lsum[t] += ps;
#pragma unroll
      for (int ks = 0; ks < 2; ++ks) { u32x4 w; w.x = cvtpk(p[8 * ks], p[8 * ks + 1]); w.y = cvtpk(p[8 * ks + 2], p[8 * ks + 3]); w.z = cvtpk(p[8 * ks + 4], p[8 * ks + 5]); w.w = cvtpk(p[8 * ks + 6], p[8 * ks + 7]); pb[t][ks] = __builtin_bit_cast(bf16x8, w); }
    }
#pragma unroll
    for (int ks = 0; ks < 2; ++ks)
#pragma unroll
      for (int db = 0; db < 2; ++db) {
        const bf16x8 a = (bf16x8){vf[ks][db][0][0], vf[ks][db][0][1], vf[ks][db][0][2], vf[ks][db][0][3], vf[ks][db][1][0], vf[ks][db][1][1], vf[ks][db][1][2], vf[ks][db][1][3]};
#pragma unroll
        for (int t = 0; t < 2; ++t) st.o[t][db] = MFMA32(a, pb[t][ks], st.o[t][db]);
      }
  }
}
__device__ __forceinline__ float attn_finish32(Acc32& st) {
  auto b = __builtin_amdgcn_permlane32_swap(__float_as_uint(st.lsum), __float_as_uint(st.lsum), false, false);
  const float lt = __uint_as_float(b[0]) + __uint_as_float(b[1]) + st.lx;
  const float inv = lt > 0.f ? __builtin_amdgcn_rcpf(lt) : 0.f;
#pragma unroll
  for (int r = 0; r < 16; ++r) { st.o[0][r] *= inv; st.o[1][r] *= inv; }
  return lt;
}
__device__ __forceinline__ void gated_store32(u16* mixrow, const f32x16 (&o)[2], int hh) {
#pragma unroll
  for (int db = 0; db < 2; ++db)
#pragma unroll
    for (int rg = 0; rg < 4; ++rg) {
      u32x2* p = (u32x2*)(mixrow + 32 * db + 8 * rg + 4 * hh); const u32x2 z = *p;
      u32x2 w; w.x = cvtpk(o[db][4 * rg] * bflo(z.x), o[db][4 * rg + 1] * bfhi(z.x)); w.y = cvtpk(o[db][4 * rg + 2] * bflo(z.y), o[db][4 * rg + 3] * bfhi(z.y)); *p = w;
    }
}
__device__ __forceinline__ int vblock() { return (gridDim.x & 7) == 0 ? (int)((blockIdx.x & 7) * (gridDim.x >> 3) + (blockIdx.x >> 3)) : (int)blockIdx.x; }

__device__ __forceinline__ void swa_unit(char* lds, const Params& p, int b, int kvh, int tile) {
  const int tid = threadIdx.x, lane = tid & 63, wid = __builtin_amdgcn_readfirstlane(tid >> 6), l31 = lane & 31, hh = lane >> 5;
  unsigned char* ws = p.ws;
  const u16* kv = (const u16*)(ws + L0_KVB) + (size_t)b * SEQ * 256;
  const int q0 = tile * 64, qw = q0 + wid * 8;
  const int qpos = qw + (l31 >> 2), head = kvh * 4 + (l31 & 3);
  const float kbound = 8.08f * wave_maxf(fabsf(p.in[I_B_QKN][64 + lane]));
  bf16x8 qf[4];
  { const u16* qr = (const u16*)(ws + L0_QB) + ((size_t)(b * SEQ + qpos)) * 512 + head * 64 + 8 * hh;
#pragma unroll
    for (int kk = 0; kk < 4; ++kk) qf[kk] = *(const bf16x8*)(qr + 16 * kk); }
  const float sink = p.in[I_B_SINKS][head] * LOG2E;
  const float shift = fmaxf(qrow_norm32<4>(qf) * kbound, sink);
  Acc32 st; acc32_start(st, shift);
  st.lx = __builtin_amdgcn_exp2f(sink - shift);
  const int kfirst = q0 >= 128 ? q0 - 128 : 0, klast = q0 + 63;
  attn_run32<4, false>(lds, kv + kvh * 64, 256, kv + 128 + kvh * 64, 256, nullptr, kfirst, klast, SEQ - 1, qf, st, qpos - 127, qpos, qw - 127, qw + 7, tid, lane);
  attn_finish32(st);
  gated_store32((u16*)(ws + WS_MIX) + ((size_t)(b * SEQ + qpos)) * 1024 + 512 + head * 64, st.o, hh);
}

template <int ABL = 0>
__device__ __forceinline__ void mla_unit(char* lds, const Params& p, int b, int h, int qb  , u16* outbuf) {
  const int tid = threadIdx.x, lane = tid & 63, wid = __builtin_amdgcn_readfirstlane(tid >> 6), l31 = lane & 31, hh = lane >> 5;
  unsigned char* ws = p.ws;
  const size_t tb = (size_t)b * SEQ;
  const int q0 = qb * 512, qw = q0 + wid * 64;
  const float gn = wave_maxf(fabsf(p.in[I_D_NOPEN][64 + lane])), gr = wave_maxf(fabsf(p.in[I_D_ROPEN][32 + (lane & 31)]));
  const float kbound = 1.01f * __builtin_sqrtf(64.f * gn * gn + 32.f * gr * gr);
  bf16x8 qf[2][6]; int hi[2];
  Acc32x2 st;
#pragma unroll
  for (int t = 0; t < 2; ++t) {
    const int qpos = qw + 32 * t + l31;
    const u16* qr = (const u16*)(ws + L1_QM) + (tb + qpos) * 768 + h * 96 + 8 * hh;
#pragma unroll
    for (int kk = 0; kk < 6; ++kk) qf[t][kk] = *(const bf16x8*)(qr + 16 * kk);
    hi[t] = qpos; st.m[t] = qrow_norm32<6>(qf[t]) * kbound; st.lsum[t] = 0.f;
#pragma unroll
    for (int r = 0; r < 16; ++r) { st.o[t][0][r] = 0.f; st.o[t][1][r] = 0.f; }
  }
  const u16* Kg = (const u16*)(ws + L1_KN) + tb * 512 + h * 64; const u16* Vg = (const u16*)(ws + L1_VM) + tb * 512 + h * 64; const u16* Rg = (const u16*)(ws + L1_KROPE) + tb * 32;
  const int klast = q0 + 511, whi = qw + 63;
  ChunkRegs crA, crB;
  chunk_fetch<true>(crA, Kg, 512, Vg, 512, Rg, 0, SEQ - 1, tid);
  chunk_fetch<true>(crB, Kg, 512, Vg, 512, Rg, 64, SEQ - 1, tid);
  int it = 0;
  for (int kb = 0; kb <= klast; kb += 128, it ^= 1) {
    char* bufA = lds + (2 * it) * CH_BYTES_ROPE; char* bufB = bufA + CH_BYTES_ROPE;
    chunk_store<true, true>(crA, bufA, tid);
    chunk_store<true, true>(crB, bufB, tid);
    __syncthreads();
    chunk_fetch<true>(crA, Kg, 512, Vg, 512, Rg, kb + 128, SEQ - 1, tid);
    chunk_fetch<true>(crB, Kg, 512, Vg, 512, Rg, kb + 192, SEQ - 1, tid);
    if (kb <= whi) {
      const bool nm = kb + 127 > qw;
      attn_steps32x2<6, 4>(bufA, bufB, qf, st, nm, hi, kb, lane);
    }
  }
  __syncthreads();
#pragma unroll
  for (int t = 0; t < 2; ++t) {
    auto bsw = __builtin_amdgcn_permlane32_swap(__float_as_uint(st.lsum[t]), __float_as_uint(st.lsum[t]), false, false);
    const float lt = __uint_as_float(bsw[0]) + __uint_as_float(bsw[1]);
    const float inv = lt > 0.f ? __builtin_amdgcn_rcpf(lt) : 0.f;
#pragma unroll
    for (int r = 0; r < 16; ++r) { st.o[t][0][r] *= inv; st.o[t][1][r] *= inv; }
    gated_store32(outbuf + (tb + qw + 32 * t + l31) * 1024 + 512 + h * 64, st.o[t], hh);
  }
}
constexpr int NSA_IMP = 2 * CH_BYTES;
constexpr int NSA_SEL = 4 * CH_BYTES;
constexpr int NSA_RES = NSA_SEL + 1024;
constexpr int NSA_LDS = NSA_RES + 65536;

__device__ __forceinline__ unsigned wave_max_u32(unsigned v) {
  v = max(v, (unsigned)__builtin_amdgcn_update_dpp(0, (int)v, 0xB1, 0xF, 0xF, true));
  v = max(v, (unsigned)__builtin_amdgcn_update_dpp(0, (int)v, 0x4E, 0xF, 0xF, true));
  v = max(v, (unsigned)__builtin_amdgcn_update_dpp(0, (int)v, 0x141, 0xF, 0xF, true));
  v = max(v, (unsigned)__builtin_amdgcn_update_dpp(0, (int)v, 0x140, 0xF, 0xF, true));
  const unsigned a = __builtin_amdgcn_readlane(v, 0), b = __builtin_amdgcn_readlane(v, 16), c = __builtin_amdgcn_readlane(v, 32), d = __builtin_amdgcn_readlane(v, 48);
  return max(max(a, b), max(c, d));
}
__device__ __forceinline__ float quad_sum(float v) {
  v += __int_as_float(__builtin_amdgcn_update_dpp(0, __float_as_int(v), 0xB1, 0xF, 0xF, true));
  v += __int_as_float(__builtin_amdgcn_update_dpp(0, __float_as_int(v), 0x4E, 0xF, 0xF, true));
  return v;
}
__device__ __forceinline__ float wave_max(float v) {
#pragma unroll
  for (int o = 1; o < 64; o <<= 1) v = fmaxf(v, __shfl_xor(v, o));
  return v;
}

template <int ABL = 0>
__device__ __forceinline__ void nsa_unit(char* lds, const Params& p, int b, int kvh, int tile, u16* outbuf) {
  const int tid = threadIdx.x, lane = tid & 63, wid = __builtin_amdgcn_readfirstlane(tid >> 6), fr = lane & 15, fq = lane >> 4;
  unsigned char* ws = p.ws;
  const size_t tb = (size_t)b * SEQ;
  const int q0 = tile * 64, qw = q0 + wid * 8;
  float* imp = (float*)(lds + NSA_IMP) + wid * 1024;
  unsigned* selw = (unsigned*)(lds + NSA_SEL) + wid * 32;
  bf16x8 qf[2][2]; int qpos[2], lo[2], hi[2];
#pragma unroll
  for (int nt = 0; nt < 2; ++nt) {
    qpos[nt] = qw + 4 * nt + (fr >> 2);
    const u16* qr = (const u16*)(ws + L1_QC) + (tb + qpos[nt]) * 512 + (kvh * 4 + (fr & 3)) * 64 + 8 * fq;
    qf[nt][0] = *(const bf16x8*)qr; qf[nt][1] = *(const bf16x8*)(qr + 32);
  }
  f32x4* resb = (f32x4*)(lds + NSA_RES) + wid * 512 + lane;
  float qn[2];
#pragma unroll
  for (int nt = 0; nt < 2; ++nt) qn[nt] = qrow_norm<2>(qf[nt]);
  const float gk0 = 8.08f * wave_maxf(fabsf(p.in[I_C_KN][lane])), gk1 = 8.08f * wave_maxf(fabsf(p.in[I_C_KN][64 + lane])), gk2 = 8.08f * wave_maxf(fabsf(p.in[I_C_KN][128 + lane]));
  const float* gates = (const float*)(ws + L1_GATES);
  const u16* kc = (const u16*)(ws + L1_KCMP) + ((size_t)b * 512 * 2 + kvh) * 64; const u16* vc = (const u16*)(ws + L1_VCMP) + ((size_t)b * 512 * 2 + kvh) * 64;
  const int nlast = (q0 + 63 - 31) >> 4;
  float mfin[2], linv[2];
  {
    AttnAcc<2> st; { const float sh[2] = {qn[0] * gk0, qn[1] * gk0}; acc_start<2>(st, sh); }
#pragma unroll
    for (int nt = 0; nt < 2; ++nt) { lo[nt] = 0; hi[nt] = qpos[nt] >= 31 ? ((qpos[nt] - 31) >> 4) : -1; }
    const int whi = (qw + 7 >= 31) ? ((qw + 7 - 31) >> 4) : -1;
    attn_run<2, 2, false>(lds, kc, 128, vc, 128, nullptr, 0, nlast, 510, qf, st, lo, hi, 0, whi, tid, lane);
    attn_finish<2>(st);
#pragma unroll
    for (int nt = 0; nt < 2; ++nt) {
      mfin[nt] = st.m[nt]; linv[nt] = st.l[nt] > 0.f ? __builtin_amdgcn_rcpf(st.l[nt]) : 0.f;
      const float g = gates[(tb + qpos[nt]) * 24 + (kvh * 4 + (fr & 3)) * 3 + 0];
#pragma unroll
      for (int dt = 0; dt < 4; ++dt) resb[(nt * 4 + dt) * 64] = st.o[nt][dt] * g;
    }
    if (!(ABL & 8)) {
#pragma unroll
    for (int i = 0; i < 4; ++i) *(f32x4*)(imp + (i * 64 + lane) * 4) = (f32x4){0.f, 0.f, 0.f, 0.f};
    ChunkRegs cr; chunk_fetch<false>(cr, kc, 128, vc, 128, nullptr, 0, 510, tid);
    int it = 0;
    for (int kb = 0; kb <= nlast; kb += 64, ++it) {
      char* buf = lds + (it & 1) * CH_BYTES;
      chunk_store<false>(cr, buf, tid);
      __syncthreads();
      if (kb + 64 <= nlast) chunk_fetch<false>(cr, kc, 128, vc, 128, nullptr, kb + 64, 510, tid);
      if (kb <= whi) {
        const int ksw = (fr >> 1) & 7;
#pragma unroll
        for (int kt4 = 0; kt4 < 4; ++kt4) {
          f32x4 sc2[2] = {(f32x4){0.f, 0.f, 0.f, 0.f}, (f32x4){0.f, 0.f, 0.f, 0.f}};
#pragma unroll
          for (int kk = 0; kk < 2; ++kk) {
            const bf16x8 a = *(const bf16x8*)(buf + CH_K + (16 * kt4 + fr) * 128 + (((fq + 4 * kk) ^ ksw) << 4));
#pragma unroll
            for (int nt = 0; nt < 2; ++nt) sc2[nt] = MFMA16(a, qf[nt][kk], sc2[nt]);
          }
#pragma unroll
          for (int nt = 0; nt < 2; ++nt) {
            float pr[4];
#pragma unroll
            for (int r = 0; r < 4; ++r) { const int key = kb + 16 * kt4 + 4 * fq + r; pr[r] = (key <= hi[nt]) ? __builtin_amdgcn_exp2f(sc2[nt][r] - mfin[nt]) * linv[nt] : 0.f; }
            float A = 2.f * (pr[0] + pr[1] + pr[2]) + pr[3], B = pr[3];
            A = quad_sum(A); B = quad_sum(B);
            if ((fr & 3) == 0) {
              const int jb = (kb >> 2) + 4 * kt4 + fq; float* row = imp + (4 * nt + (fr >> 2)) * 128;
              atomicAdd(row + jb, A);
              if (jb + 1 < 128) atomicAdd(row + jb + 1, B);
            }
          }
        }
      }
    }
    __syncthreads();
    }
  }
  if (!(ABL & 1)) {
    unsigned char* selb = (unsigned char*)selw;
    int lane_s = lane; asm volatile("" : "+v"(lane_s));
#pragma unroll 1
    for (int half = 0; half < 2; ++half) {
      const int qq = 4 * half + (lane_s >> 4), l16 = lane_s & 15;
      const int t = qw + qq, cur = t >> 6;
      const f32x4 i0 = *(const f32x4*)(imp + qq * 128 + 8 * l16), i1 = *(const f32x4*)(imp + qq * 128 + 8 * l16 + 4);
      const float iv[8] = {i0.x, i0.y, i0.z, i0.w, i1.x, i1.y, i1.z, i1.w};
      unsigned key[8]; unsigned flags = 0u;
#pragma unroll
      for (int i = 0; i < 8; ++i) {
        const int j = 8 * l16 + i;
        const bool small = cur + 1 <= 16;
        if (small ? (j <= cur) : (j == 0 || j == cur || j == cur - 1)) flags |= 1u << i;
        key[i] = (!small && j >= 1 && j <= cur - 2) ? ((__float_as_uint(iv[i]) & ~127u) | (unsigned)(127 - j)) : 0u;
      }
      for (int rnd = 0; rnd < 13; ++rnd) {
        unsigned m = max(max(max(key[0], key[1]), max(key[2], key[3])), max(max(key[4], key[5]), max(key[6], key[7])));
        m = max(m, (unsigned)__builtin_amdgcn_update_dpp(0, (int)m, 0xB1, 0xF, 0xF, true));
        m = max(m, (unsigned)__builtin_amdgcn_update_dpp(0, (int)m, 0x4E, 0xF, 0xF, true));
        m = max(m, (unsigned)__builtin_amdgcn_update_dpp(0, (int)m, 0x141, 0xF, 0xF, true));
        m = max(m, (unsigned)__builtin_amdgcn_update_dpp(0, (int)m, 0x140, 0xF, 0xF, true));
#pragma unroll
        for (int i = 0; i < 8; ++i) if (m != 0u && key[i] == m) { key[i] = 0u; flags |= 1u << i; }
      }
      selb[qq * 16 + l16] = (unsigned char)flags;
    }
  }
  __builtin_amdgcn_wave_barrier();
  if (!(ABL & 2))
  {
    AttnAcc<2> st; { const float sh[2] = {qn[0] * gk1, qn[1] * gk1}; acc_start<2>(st, sh); }
    const u16* kg = (const u16*)(ws + L1_KVS) + tb * 256 + kvh * 64; const u16* vg = kg + 128;
    ChunkRegs crA, crB; chunk_fetch<false>(crA, kg, 256, vg, 256, nullptr, 0, SEQ - 1, tid);
    chunk_fetch<false>(crB, kg, 256, vg, 256, nullptr, 64, SEQ - 1, tid);
    int it = 0;
    for (int j2 = 0; j2 <= tile; j2 += 2, it ^= 1) {
      char* bufA = lds + (2 * it) * CH_BYTES; char* bufB = bufA + CH_BYTES;
      chunk_store<false>(crA, bufA, tid);
      chunk_store<false>(crB, bufB, tid);
      __syncthreads();
      chunk_fetch<false>(crA, kg, 256, vg, 256, nullptr, (j2 + 2) * 64, SEQ - 1, tid);
      chunk_fetch<false>(crB, kg, 256, vg, 256, nullptr, (j2 + 3) * 64, SEQ - 1, tid);
      unsigned tmA = 0, tmB = 0; int hiA[2], hiB[2];
#pragma unroll
      for (int nt = 0; nt < 2; ++nt) {
        const unsigned word = selw[(4 * nt + (fr >> 2)) * 4 + (j2 >> 5)];
        const bool sA = (word >> (j2 & 31)) & 1u, sB = ((word >> ((j2 & 31) + 1)) & 1u) && (j2 + 1 <= tile);
        lo[nt] = 0; hiA[nt] = sA ? qpos[nt] : -1; hiB[nt] = sB ? qpos[nt] : -1;
        if (__any(sA)) tmA |= 1u << nt;
        if (__any(sB)) tmB |= 1u << nt;
      }
      const bool dg = 64 * j2 + 127 > qw;
      if (tmA == 3u && tmB == 3u) attn_steps<2, 2, 3, 4, 0, true>(bufA, bufB, qf, st, dg, lo, hiA, hiB, 64 * j2, lane);
      else {
        if (tmA == 3u) attn_steps<2, 2, 3, 2, 0, true>(bufA, bufA, qf, st, dg, lo, hiA, hiA, 64 * j2, lane);
        else if (tmA == 1u) attn_steps<2, 2, 1, 2, 0, true>(bufA, bufA, qf, st, dg, lo, hiA, hiA, 64 * j2, lane);
        else if (tmA == 2u) attn_steps<2, 2, 2, 2, 0, true>(bufA, bufA, qf, st, dg, lo, hiA, hiA, 64 * j2, lane);
        if (tmB == 3u) attn_steps<2, 2, 3, 2, 0, true>(bufB, bufB, qf, st, dg, lo, hiB, hiB, 64 * j2 + 64, lane);
        else if (tmB == 1u) attn_steps<2, 2, 1, 2, 0, true>(bufB, bufB, qf, st, dg, lo, hiB, hiB, 64 * j2 + 64, lane);
        else if (tmB == 2u) attn_steps<2, 2, 2, 2, 0, true>(bufB, bufB, qf, st, dg, lo, hiB, hiB, 64 * j2 + 64, lane);
      }
    }
    __syncthreads();
    attn_finish<2>(st);
#pragma unroll
    for (int nt = 0; nt < 2; ++nt) {
      const float g = gates[(tb + qpos[nt]) * 24 + (kvh * 4 + (fr & 3)) * 3 + 1];
#pragma unroll
      for (int dt = 0; dt < 4; ++dt) resb[(nt * 4 + dt) * 64] += st.o[nt][dt] * g;
    }
  }
  if (!(ABL & 4))
  {
    AttnAcc<2> st; { const float sh[2] = {qn[0] * gk2, qn[1] * gk2}; acc_start<2>(st, sh); }
#pragma unroll
    for (int nt = 0; nt < 2; ++nt) { lo[nt] = qpos[nt] - 511; hi[nt] = qpos[nt]; }
    const u16* kg = (const u16*)(ws + L1_KVW) + tb * 256 + kvh * 64;
    attn_run<2, 2, false>(lds, kg, 256, kg + 128, 256, nullptr, q0 >= 512 ? q0 - 512 : 0, q0 + 63, SEQ - 1, qf, st, lo, hi, qw - 511, qw + 7, tid, lane);
    attn_finish<2>(st);
#pragma unroll
    for (int nt = 0; nt < 2; ++nt) {
      const float g = gates[(tb + qpos[nt]) * 24 + (kvh * 4 + (fr & 3)) * 3 + 2];
#pragma unroll
      for (int dt = 0; dt < 4; ++dt) resb[(nt * 4 + dt) * 64] += st.o[nt][dt] * g;
    }
  }
#pragma unroll
  for (int nt = 0; nt < 2; ++nt) { f32x4 res[4];
#pragma unroll
    for (int dt = 0; dt < 4; ++dt) res[dt] = resb[(nt * 4 + dt) * 64];
    gated_store(outbuf + (tb + qpos[nt]) * 1024 + (kvh * 4 + (fr & 3)) * 64, res, fq); }
}

__device__ __forceinline__ void cmp_unit(char* lds, const Params& p, int which, int mblk) {
  const int tid = threadIdx.x, lane = tid & 63, wid = __builtin_amdgcn_readfirstlane(tid >> 6), fr = lane & 15, fq = lane >> 4;
  unsigned char* ws = p.ws;
  const u16* src = (const u16*)(ws + (which == 0 ? L1_KCR : L1_VCR));
  const u16* w1t = (const u16*)(ws + WS_WC1T) + (size_t)which * 128 * 2048;
  const u16* w2t = (const u16*)(ws + WS_WC2T) + (size_t)which * 64 * 128;
  const float* cb = (const float*)(ws + WS_CBIAS) + which * 128;
  u16* H = (u16*)lds;
  float* O = (float*)(lds + 16384);
  float* RS = (float*)(lds + 32768);
  const int m0 = mblk * 32;
  const u16* arow[2];
#pragma unroll
  for (int mt = 0; mt < 2; ++mt) { int m = m0 + 16 * mt + fr; if (m > 4087) m = 4087; const int bn = m >> 1, kv = m & 1, bb = bn / 511, n = bn % 511; arow[mt] = src + ((size_t)(bb * SEQ + 16 * n)) * 128 + kv * 64 + 8 * fq; }
  const u16* brow = w1t + (size_t)(16 * wid + fr) * 2048 + 8 * fq;
  f32x4 acc[2] = {(f32x4){0.f, 0.f, 0.f, 0.f}, (f32x4){0.f, 0.f, 0.f, 0.f}};
#pragma unroll 4
  for (int ks = 0; ks < 64; ++ks) {
    const int aoff = (ks >> 1) * 128 + (ks & 1) * 32;
    const bf16x8 a0 = *(const bf16x8*)(arow[0] + aoff), a1 = *(const bf16x8*)(arow[1] + aoff), bb = *(const bf16x8*)(brow + ks * 32);
    acc[0] = MFMA16(bb, a0, acc[0]); acc[1] = MFMA16(bb, a1, acc[1]);
  }
  {
    const f32x4 bias = *(const f32x4*)(cb + 16 * wid + 4 * fq);
#pragma unroll
    for (int mt = 0; mt < 2; ++mt) {
      u32x2 w; w.x = cvtpk(silu_f(acc[mt][0] + bias[0]), silu_f(acc[mt][1] + bias[1])); w.y = cvtpk(silu_f(acc[mt][2] + bias[2]), silu_f(acc[mt][3] + bias[3]));
      *(u32x2*)(H + (16 * mt + fr) * 136 + 16 * wid + 4 * fq) = w;
    }
  }
  __syncthreads();
  if (wid < 4) {
    f32x4 a2[2] = {(f32x4){0.f, 0.f, 0.f, 0.f}, (f32x4){0.f, 0.f, 0.f, 0.f}};
#pragma unroll
    for (int ks = 0; ks < 4; ++ks) {
      const bf16x8 bb = *(const bf16x8*)(w2t + (size_t)(16 * wid + fr) * 128 + 32 * ks + 8 * fq);
#pragma unroll
      for (int mt = 0; mt < 2; ++mt) { const bf16x8 a = *(const bf16x8*)(H + (16 * mt + fr) * 136 + 32 * ks + 8 * fq); a2[mt] = MFMA16(bb, a, a2[mt]); }
    }
#pragma unroll
    for (int mt = 0; mt < 2; ++mt)
#pragma unroll
      for (int r = 0; r < 4; ++r) O[(16 * mt + fr) * 65 + 16 * wid + 4 * fq + r] = a2[mt][r];
  }
  __syncthreads();
  if (which == 0 && tid < 32) { float ss = 0.f; for (int c = 0; c < 64; ++c) { const float v = O[tid * 65 + c]; ss += v * v; } RS[tid] = __builtin_amdgcn_rsqf(ss * (1.f / 64.f) + EPS); }
  __syncthreads();
  {
    const f32x2* rope64 = (const f32x2*)(ws + WS_ROPE64); const float* gk = p.in[I_C_KN];
    u16* dstb = (u16*)(ws + (which == 0 ? L1_KCMP : L1_VCMP));
#pragma unroll
    for (int e = 0; e < 2; ++e) {
      const int item = tid + 512 * e, row = item >> 5, i = item & 31, m = m0 + row;
      if (m <= 4087) {
        const int bn = m >> 1, kv = m & 1, bb = bn / 511, n = bn % 511;
        float a = O[row * 65 + i], c = O[row * 65 + i + 32];
        if (which == 0) {
          const float rs = RS[row]; a *= rs * gk[i]; c *= rs * gk[i + 32];
          const f32x2 cs = rope64[(16 * n + 31) * 32 + i];
          const float a2 = a * cs.x - c * cs.y, c2 = c * cs.x + a * cs.y; a = a2; c = c2;
        }
        u16* d = dstb + ((size_t)(bb * 512 + n) * 2 + kv) * 64;
        d[i] = (u16)(cvtpk(a, 0.f) & 0xffffu); d[i + 32] = (u16)(cvtpk(c, 0.f) & 0xffffu);
      }
    }
  }
  __syncthreads();
}
typedef float f32x16 __attribute__((ext_vector_type(16)));
#define MFMA32(a, b, c) __builtin_amdgcn_mfma_f32_32x32x16_bf16((a), (b), (c), 0, 0, 0)
constexpr int DSA_KI = 131072;
constexpr int DSA_LDS = DSA_KI + 16384;

__device__ __forceinline__ int wave_incl_scan(int v) {
  v += __builtin_amdgcn_update_dpp(0, v, 0x111, 0xF, 0xF, false);
  v += __builtin_amdgcn_update_dpp(0, v, 0x112, 0xF, 0xF, false);
  v += __builtin_amdgcn_update_dpp(0, v, 0x114, 0xF, 0xF, false);
  v += __builtin_amdgcn_update_dpp(0, v, 0x118, 0xF, 0xF, false);
  v += __builtin_amdgcn_update_dpp(0, v, 0x142, 0xA, 0xF, false);
  v += __builtin_amdgcn_update_dpp(0, v, 0x143, 0xC, 0xF, false);
  return v;
}
template <int NB>
__device__ __forceinline__ void find_bin(const unsigned* hist, int need, int lane, int& bin, int& above) {
  constexpr int PER = NB / 64, W = PER / 2;
  int cnt[PER];
#pragma unroll
  for (int i = 0; i < W / 4; ++i) { const u32x4 v = *(const u32x4*)(hist + lane * W + 4 * i);
#pragma unroll
    for (int k = 0; k < 4; ++k) { cnt[8 * i + 2 * k] = (int)(v[k] & 0xffffu); cnt[8 * i + 2 * k + 1] = (int)(v[k] >> 16); } }
  int s = 0;
#pragma unroll
  for (int i = 0; i < PER; ++i) s += cnt[i];
  const int incl_ = wave_incl_scan(s);
  const int S = __builtin_amdgcn_readlane(incl_, 63) - incl_ + s;
  const bool is = (S >= need) && (S - s < need);
  int mybin = 0, myabove = 0;
  {
    int run = S - s; bool done = false;
#pragma unroll
    for (int i = PER - 1; i >= 0; --i) { if (!done) { if (run + cnt[i] >= need) { mybin = lane * PER + i; myabove = run; done = true; } else run += cnt[i]; } }
  }
  const unsigned long long bal = __ballot(is);
  const int src = bal ? (__ffsll((long long)bal) - 1) : 0;
  bin = __shfl(mybin, src); above = __shfl(myabove, src);
}

typedef short s16x2 __attribute__((ext_vector_type(2)));
__device__ __forceinline__ float dot2_relu(float x0, float x1, float wpair  , float acc) {
  const f32x2 v = {x0, x1}; const s16x2 pi = __builtin_bit_cast(s16x2, __builtin_convertvector(v, bf16x2_t)); const s16x2 z = {0, 0};
  return __builtin_amdgcn_fdot2_f32_bf16(__builtin_bit_cast(bf16x2_t, __builtin_elementwise_max(pi, z)), __builtin_bit_cast(bf16x2_t, wpair), acc, false);
}
__device__ __forceinline__ void wr_lane2(int& a, int& b, int lo, int hi, int lane_sel) {
  asm volatile("s_mov_b32 m0, %4\n\ts_nop 0\n\tv_writelane_b32 %0, %2, m0\n\tv_writelane_b32 %1, %3, m0" : "+v"(a), "+v"(b) : "s"(lo), "s"(hi), "s"(lane_sel) : "m0");
}
#ifndef DSA_SKEW_MASK
#define DSA_SKEW_MASK 0
#endif
__device__ __forceinline__ float relu_f(float x) { float r; asm("v_max_f32_e32 %0, 0, %1" : "=v"(r) : "v"(x)); return r; }
template <int MODE, bool MASKED, int ABL = 0>
__device__ __forceinline__ void dsa_tile(const f32x16& C, int k0, int qw, const f32x4 (&wq)[4], const float (&sq)[4], const int (&b1)[4], const int (&T19)[4], const int (&rtie)[4],
                                         int (&outcnt)[4], int (&tiecnt)[4], int (&gtm)[8], unsigned* hist, u16* idxl, int l31, int hh) {
  const int kabs = k0 + l31;
  const int tl = __builtin_amdgcn_readfirstlane((k0 >> 5) & 63);
#pragma unroll
  for (int g = 0; g < 4; ++g) {
    const float sc = __builtin_fmaf(wq[g][3], relu_f(C[4 * g + 3]), __builtin_fmaf(wq[g][2], relu_f(C[4 * g + 2]), __builtin_fmaf(wq[g][1], relu_f(C[4 * g + 1]), __builtin_fmaf(wq[g][0], relu_f(C[4 * g]), 0.f))));
    const unsigned k19 = min((unsigned)(int)__builtin_fmaf(sc, sq[g], 262144.f), 524287u);
    const bool valid = MASKED ? (kabs <= qw + 2 * g + hh) : true;
    unsigned* hq = hist + (2 * g + hh) * 512;
    if (MODE == 1) { if (valid) {
      const unsigned bin = k19 >> 9;
      if (ABL & 32) __hip_atomic_store(hq + (bin >> 1), 1u << ((bin & 1) * 16), __ATOMIC_RELAXED, __HIP_MEMORY_SCOPE_WORKGROUP);
      else atomicAdd(hq + (bin >> 1), 1u + (bin & 1u) * 0xffffu);
    } }
    else {
      const bool gt = valid && (int)k19 >= ((b1[g] + 1) << 9), eq = valid && (int)k19 >= (b1[g] << 9) && !gt;
      const unsigned long long bs = __ballot(gt);
      wr_lane2(gtm[2 * g], gtm[2 * g + 1], __builtin_amdgcn_readfirstlane((int)(unsigned)bs), __builtin_amdgcn_readfirstlane((int)(unsigned)(bs >> 32)), tl);
      const unsigned long long bc = __ballot(eq);
      if (bc) {
        const unsigned below = (1u << l31) - 1u;
        const unsigned hc = (unsigned)(hh ? (bc >> 32) : bc);
        const int cpos = tiecnt[g] + (int)__popc(hc & below);
        if (eq) {
          const unsigned ent = ((k19 & 511u) << 16) | (unsigned)kabs;
          if (cpos < 128) ((unsigned*)((char*)idxl + 4096))[(2 * g + hh) * 128 + cpos] = ent;
          else if (cpos < 2048) __hip_atomic_store(hist + ((unsigned)(2 * g * 2048) + (unsigned)(hh * 2048) + (unsigned)cpos), ent, __ATOMIC_RELAXED, __HIP_MEMORY_SCOPE_AGENT);
        }
        tiecnt[g] += (int)__popc(hc);
      }
    }
  }
}
template <int MODE, int ABL = 0>
__device__ __forceinline__ void dsa_valu(const f32x16& C0, const f32x16& C1, int kb, int tmaxw, int qw, const f32x4 (&wq)[4], const float (&sq)[4], const int (&b1)[4], const int (&T19)[4], const int (&rtie)[4],
                                         int (&outcnt)[4], int (&tiecnt)[4], int (&gtm)[8], unsigned* hist, u16* idxl, int lane) {
  const int l31 = lane & 31, hh = lane >> 5;
  if (kb + 31 <= qw) dsa_tile<MODE, false, ABL>(C0, kb, qw, wq, sq, b1, T19, rtie, outcnt, tiecnt, gtm, hist, idxl, l31, hh);
  else dsa_tile<MODE, true, ABL>(C0, kb, qw, wq, sq, b1, T19, rtie, outcnt, tiecnt, gtm, hist, idxl, l31, hh);
  if (kb + 32 <= tmaxw) {
    if (kb + 63 <= qw) dsa_tile<MODE, false, ABL>(C1, kb + 32, qw, wq, sq, b1, T19, rtie, outcnt, tiecnt, gtm, hist, idxl, l31, hh);
    else dsa_tile<MODE, true, ABL>(C1, kb + 32, qw, wq, sq, b1, T19, rtie, outcnt, tiecnt, gtm, hist, idxl, l31, hh);
  }
}
template <int MODE, int ABL = 0>
__device__ __forceinline__ void dsa_pass(char* lds, const u16* __restrict__ kig, int klast, int tmaxw, int qw, const bf16x8 (&qf)[4], const f32x4 (&wq)[4], const float (&sq)[4],
                                         const int (&b1)[4], const int (&T19)[4], const int (&rtie)[4], unsigned* hist, u16* idxl, int tid, int lane, int (&outcnt)[4], int (&tiecnt)[4]) {
#pragma unroll
  for (int g = 0; g < 4; ++g) { outcnt[g] = 0; tiecnt[g] = 0; }
  int gtm[8] = {0, 0, 0, 0, 0, 0, 0, 0};
  unsigned* bm = (unsigned*)((char*)idxl + 8192);
  if (MODE == 4) {
#pragma unroll
    for (int i = 0; i < 8; ++i) *(u32x4*)(bm + (i * 64 + lane) * 4) = (u32x4){0u, 0u, 0u, 0u};
  }
#define DSA_FLUSH(W) do { _Pragma("unroll") for (int q_ = 0; q_ < 8; ++q_) { bm[q_ * 256 + (W) * 64 + lane] = (unsigned)gtm[q_]; gtm[q_] = 0; } } while (0)
  if (MODE < 3) {
#pragma unroll
    for (int i = 0; i < 16; ++i) *(u32x4*)(hist + (i * 64 + lane) * 4) = (u32x4){0u, 0u, 0u, 0u};
  }
  asm volatile("" : "+v"(tid), "+v"(lane));
  const u16* src = kig + (size_t)(tid >> 3) * 64 + (tid & 7) * 8;
  const unsigned dsto = kimg_off(tid >> 3, tid & 7);
  const int l31 = lane & 31, hh = lane >> 5, ksw = (l31 >> 1) & 7;
  const unsigned koff = (unsigned)(l31 * 128);
  const f32x16 Z = {0.f, 0.f, 0.f, 0.f, 0.f, 0.f, 0.f, 0.f, 0.f, 0.f, 0.f, 0.f, 0.f, 0.f, 0.f, 0.f};
  f32x16 P0 = Z, P1 = Z;
#define DSA_LD(KB) (*(const u32x4*)(src + (size_t)((KB) < SEQ - 64 ? (KB) : SEQ - 64) * 64))
  u32x4 cr0 = DSA_LD(0), cr1 = DSA_LD(64), cr2 = DSA_LD(128), cr3 = DSA_LD(192), cr4 = DSA_LD(256), cr5 = DSA_LD(320);
  const bool late = (__builtin_amdgcn_readfirstlane(tid >> 6) & DSA_SKEW_MASK) != 0;
#define DSA_MFMAS() do { P0 = MFMA32(qf[0], kf[0][0], Z); P1 = MFMA32(qf[0], kf[1][0], Z); \
    _Pragma("unroll") for (int kk = 1; kk < 4; ++kk) { P0 = MFMA32(qf[kk], kf[0][kk], P0); P1 = MFMA32(qf[kk], kf[1][kk], P1); } } while (0)
#define DSA_STEP(CR, BUFI, KB) do { const int kb = (KB); \
    char* buf = lds + DSA_KI + (BUFI) * 8192; \
    *(u32x4*)(buf + dsto) = CR; \
    __syncthreads(); \
    CR = DSA_LD(kb + 384); \
    bf16x8 kf[2][4]; \
    _Pragma("unroll") for (int sub = 0; sub < 2; ++sub) _Pragma("unroll") for (int kk = 0; kk < 4; ++kk) kf[sub][kk] = *(const bf16x8*)(buf + 32 * sub * 128 + koff + (((hh + 2 * kk) ^ ksw) << 4)); \
    if (late) DSA_MFMAS(); \
    const int kp = late ? kb : kb - 64; \
    if (!(ABL & 8) && kp >= 0 && kp <= tmaxw) dsa_valu<MODE, ABL>(P0, P1, kp, tmaxw, qw, wq, sq, b1, T19, rtie, outcnt, tiecnt, gtm, hist, idxl, lane); \
    if (MODE == 4 && kp >= 0 && ((kp + 64) & 2047) == 0 && kp + 64 <= tmaxw) DSA_FLUSH(kp >> 11); \
    if (!late) DSA_MFMAS(); } while (0)
  for (int kb6 = 0; kb6 <= klast; kb6 += 384) {
    DSA_STEP(cr0, 0, kb6); DSA_STEP(cr1, 1, kb6 + 64); DSA_STEP(cr2, 0, kb6 + 128);
    DSA_STEP(cr3, 1, kb6 + 192); DSA_STEP(cr4, 0, kb6 + 256); DSA_STEP(cr5, 1, kb6 + 320);
  }
#undef DSA_STEP
#undef DSA_MFMAS
#undef DSA_LD
  { const int kbl = (klast / 384) * 384 + 320; if (!late && !(ABL & 8) && kbl <= tmaxw) dsa_valu<MODE, ABL>(P0, P1, kbl, tmaxw, qw, wq, sq, b1, T19, rtie, outcnt, tiecnt, gtm, hist, idxl, lane); }
  if (MODE == 4) DSA_FLUSH(tmaxw >> 11);
#undef DSA_FLUSH
  __syncthreads();
}

__device__ __forceinline__ unsigned pk4_fp8(float a, float b, float c, float d) { int w = 0; w = __builtin_amdgcn_cvt_pk_fp8_f32(a, b, w, false); w = __builtin_amdgcn_cvt_pk_fp8_f32(c, d, w, true); return (unsigned)w; }
__device__ __forceinline__ u32x2 fp8x4_bf16(unsigned w) {
#if defined(__HIP_DEVICE_COMPILE__)
  return (u32x2){__builtin_bit_cast(unsigned, __builtin_amdgcn_cvt_scalef32_pk_bf16_fp8(w, 1.0f, false)), __builtin_bit_cast(unsigned, __builtin_amdgcn_cvt_scalef32_pk_bf16_fp8(w, 1.0f, true))};
#else
  return (u32x2){w, w};
#endif
}
template <int ABL = 0>
__device__ __forceinline__ void dsa_unit(char* lds, const Params& p, int b, int tile, u16* outbuf) {
  const int tid = threadIdx.x, lane = tid & 63, wid = __builtin_amdgcn_readfirstlane(tid >> 6);
  const int l31 = lane & 31, hh = lane >> 5;
  unsigned char* ws = p.ws;
  const size_t tb = (size_t)b * SEQ;
  const int q0 = tile * 64, qw = q0 + wid * 8;
  char* R = lds + wid * 16384;
  unsigned* hist = (unsigned*)R;
  u16* idxl = (u16*)R;
  char* vst = R + 4096;
  const u16* kig = (const u16*)(ws + L0_KI) + tb * 64;
  bf16x8 qf[4];
  { const u16* qr = (const u16*)(ws + L0_QI) + (tb + qw + (l31 >> 2)) * 256 + (l31 & 3) * 64 + 8 * hh;
#pragma unroll
    for (int kk = 0; kk < 4; ++kk) qf[kk] = *(const bf16x8*)(qr + 16 * kk); }
  f32x4 wq[4];
#pragma unroll
  for (int g = 0; g < 4; ++g) wq[g] = *(const f32x4*)((const float*)(ws + L0_WI) + (tb + qw + 2 * g + hh) * 4);
  float sq[4];
  { float ss = 0.f;
#pragma unroll
    for (int kk = 0; kk < 4; ++kk)
#pragma unroll
      for (int j = 0; j < 8; ++j) { const float a = bf1((u16)qf[kk][j]); ss += a * a; }
    ss += __shfl_xor(ss, 32);
    const float wr = ((const float*)(ws + L0_WI))[(tb + qw + (l31 >> 2)) * 4 + (l31 & 3)];
    float bq = fabsf(wr) * __builtin_sqrtf(ss);
    bq += __shfl_xor(bq, 1); bq += __shfl_xor(bq, 2);
    bq *= 8.f * 1.01f * wave_max(fabsf(p.in[I_A_KIDXN][lane]));
    const float sc_ = bq > 0.f ? 262142.f / bq : 0.f;
#pragma unroll
    for (int g = 0; g < 4; ++g) sq[g] = __shfl(sc_, 4 * (2 * g + hh)); }
  int b1[4] = {0, 0, 0, 0}, T19[4] = {0, 0, 0, 0}, rtie[4] = {0, 0, 0, 0}, need2[4] = {0, 0, 0, 0};
  const int klast = q0 + 63, tmaxw = qw + 7;
  int oc[4], tc[4];
  unsigned* cand = (unsigned*)(ws + L0_CAND) + ((size_t)blockIdx.x * 8 + wid) * 16384;
  if (!(ABL & 2)) dsa_pass<1, ABL>(lds, kig, klast, tmaxw, qw, qf, wq, sq, b1, T19, rtie, hist, idxl, tid, lane, oc, tc);
#pragma unroll
  for (int g = 0; g < 4; ++g) {
    int bA, aA, bB, aB;
    find_bin<1024>(hist + (2 * g) * 512, 256, lane, bA, aA);
    find_bin<1024>(hist + (2 * g + 1) * 512, 256, lane, bB, aB);
    b1[g] = hh ? bB : bA; need2[g] = 256 - (hh ? aB : aA);
    if (qw + 2 * g + hh + 1 <= 256) { b1[g] = -1; need2[g] = 0; }
  }
  if (!(ABL & 4)) dsa_pass<4, ABL>(lds, kig, klast, tmaxw, qw, qf, wq, sq, b1, T19, rtie, cand, idxl, tid, lane, oc, tc);
  asm volatile("s_waitcnt vmcnt(0) lgkmcnt(0)" ::: "memory");
  if (!(ABL & 16)) {
    int lane_r = lane; asm volatile("" : "+v"(lane_r));
    unsigned* bm = (unsigned*)(R + 8192);
    const unsigned* candl = (const unsigned*)(R + 4096);
    const unsigned long long lt = (1ull << lane_r) - 1ull;
    for (int q = 0; q < 8; ++q) {
      const int g = q >> 1, src = (q & 1) * 32;
      const int ncr = __shfl(g == 0 ? tc[0] : g == 1 ? tc[1] : g == 2 ? tc[2] : tc[3], src);
      const int nd = __shfl(g == 0 ? need2[0] : g == 1 ? need2[1] : g == 2 ? need2[2] : need2[3], src);
      unsigned* h2 = bm + q * 256;
      int pos;
      {
        const u32x4 wv = *(const u32x4*)(h2 + lane_r * 4);
        unsigned long long w0 = ((unsigned long long)wv.y << 32) | wv.x, w1 = ((unsigned long long)wv.w << 32) | wv.z;
        const int c = (int)__popcll(w0) + (int)__popcll(w1);
        const int incl = wave_incl_scan(c);
        int base = incl - c; pos = __builtin_amdgcn_readlane(incl, 63);
        const int k0_ = lane_r * 128;
        while (w0) { const int b_ = __ffsll((long long)w0) - 1; w0 &= w0 - 1ull; if (base < 256) idxl[q * 256 + base] = (u16)(k0_ + b_); ++base; }
        while (w1) { const int b_ = __ffsll((long long)w1) - 1; w1 &= w1 - 1ull; if (base < 256) idxl[q * 256 + base] = (u16)(k0_ + 64 + b_); ++base; }
      }
      if (nd <= 0) continue;
      const int nc = ncr < 2048 ? ncr : 2048;
      if (nc <= 64) {
        const bool in = lane_r < nc;
        const unsigned e = candl[q * 128 + lane_r];
        const int sub = in ? (int)(e >> 16) : -1;
        int T = 0;
#pragma unroll
        for (int bit = 8; bit >= 0; --bit) { const int tt = T | (1 << bit); if ((int)__popcll(__ballot(sub >= tt)) >= nd) T = tt; }
        const unsigned long long bgt = __ballot(sub > T), btie = __ballot(sub == T);
        const int r = nd - (int)__popcll(bgt);
        const bool sel = (sub > T) || (sub == T && (int)__popcll(btie & lt) < r);
        const unsigned long long bs = __ballot(sel);
        const int pp = pos + (int)__popcll(bs & lt);
        if (sel && pp < 256) idxl[q * 256 + pp] = (u16)(e & 0xffffu);
        continue;
      }
      const unsigned* cq = cand + q * 2048;
      *(u32x4*)(h2 + lane_r * 4) = (u32x4){0u, 0u, 0u, 0u};
      asm volatile("" ::: "memory");
      for (int i0 = 0; i0 < nc; i0 += 64) {
        const int i = i0 + lane_r;
        unsigned e;
        if (i0 < 128) e = candl[q * 128 + (i & 127)]; else e = __hip_atomic_load(cq + (i < nc ? i : 0), __ATOMIC_RELAXED, __HIP_MEMORY_SCOPE_AGENT);
        const unsigned sub = e >> 16; if (i < nc) atomicAdd(h2 + (sub >> 1), 1u << ((sub & 1) * 16));
      }
      asm volatile("s_waitcnt lgkmcnt(0)" ::: "memory");
      int b2, a2; find_bin<512>(h2, nd, lane_r, b2, a2);
      const int r = nd - a2; int ties = 0;
      for (int i0 = 0; i0 < nc; i0 += 64) {
        const int i = i0 + lane_r; const bool in = i < nc;
        unsigned e;
        if (i0 < 128) e = candl[q * 128 + (i & 127)]; else e = __hip_atomic_load(cq + (in ? i : 0), __ATOMIC_RELAXED, __HIP_MEMORY_SCOPE_AGENT);
        const int sub = (int)(e >> 16);
        const bool tie = in && sub == b2;
        const unsigned long long bt = __ballot(tie);
        const bool sel = (in && sub > b2) || (tie && (ties + (int)__popcll(bt & lt) < r));
        ties += (int)__popcll(bt);
        const unsigned long long bs = __ballot(sel);
        const int pp = pos + (int)__popcll(bs & lt);
        if (sel && pp < 256) idxl[q * 256 + pp] = (u16)(e & 0xffffu);
        pos += (int)__popcll(bs);
      }
    }
  }
  const unsigned char* kva8 = ws + L0_KVA + tb * 256;
  const float kbound = 8.f * 1.15f * wave_max(fabsf(p.in[I_A_QKN][64 + lane]));
  u32x4 ring[4][4];
  bf16x8 qn0, qn1;
#define DSA_KISSUE(slot, qi_, g2) do { const int cn_ = (qw + (qi_) + 1 < 256) ? qw + (qi_) + 1 : 256; _Pragma("unroll") for (int k2 = 0; k2 < 2; ++k2) { const int e_ = 32 * (g2) + 16 * k2 + (lane_o & 15); \
      const int tok_ = (int)idxl[(qi_) * 256 + (e_ < cn_ ? e_ : cn_ - 1)]; const unsigned char* kr_ = kva8 + (size_t)tok_ * 256 + 16 * (lane_o >> 4); \
      ring[slot][2 * k2] = *(const u32x4*)kr_; ring[slot][2 * k2 + 1] = *(const u32x4*)(kr_ + 64); } } while (0)
#define DSA_VISSUE(slot, qi_, s2_) do { const int cn_ = (qw + (qi_) + 1 < 256) ? qw + (qi_) + 1 : 256; _Pragma("unroll") for (int j = 0; j < 4; ++j) { const int e_ = 32 * (s2_) + 8 * j + (lane_o >> 3); \
      const int tok_ = (int)idxl[(qi_) * 256 + (e_ < cn_ ? e_ : cn_ - 1)]; ring[slot][j] = *(const u32x4*)(kva8 + (size_t)tok_ * 256 + 128 + 16 * (lane_o & 7)); } } while (0)
#define DSA_QISSUE(qi_) do { const u16* qr_ = (const u16*)(ws + L0_QA) + (tb + qw + (qi_)) * 512 + (lane_o & 7) * 64 + 16 * (lane_o >> 4); qn0 = *(const bf16x8*)qr_; qn1 = *(const bf16x8*)(qr_ + 8); } while (0)
  if (!(ABL & 1)) { int lane_o = lane; asm volatile("" : "+v"(lane_o)); DSA_QISSUE(0); DSA_KISSUE(0, 0, 0); DSA_KISSUE(1, 0, 1); DSA_KISSUE(2, 0, 2); }
#pragma unroll 1
  for (int qq = 0; qq < ((ABL & 1) ? 0 : 8); ++qq) {
    int lane_o = lane; asm volatile("" : "+v"(lane_o));
    const int fr = lane_o & 15, fq = lane_o >> 4;
    const int t = qw + qq, cnt = t + 1 < 256 ? t + 1 : 256;
    const int qnx = qq + 1 < 8 ? qq + 1 : 7;
    long qb[4]; float shift;
    {
      const bf16x8 qa0 = qn0, qa1 = qn1;
      float f0[8], f1[8], qn = 0.f;
#pragma unroll
      for (int j = 0; j < 8; ++j) { f0[j] = bf1((u16)qa0[j]); f1[j] = bf1((u16)qa1[j]); qn += f0[j] * f0[j] + f1[j] * f1[j]; }
      qn = rsum4(qn); shift = (fr < 8) ? __builtin_sqrtf(qn) * kbound : 0.f;
      const u32x2 lo = {pk4_fp8(f0[0] * 8.f, f0[1] * 8.f, f0[2] * 8.f, f0[3] * 8.f), pk4_fp8(f0[4] * 8.f, f0[5] * 8.f, f0[6] * 8.f, f0[7] * 8.f)};
      const u32x2 hi = {pk4_fp8(f1[0] * 8.f, f1[1] * 8.f, f1[2] * 8.f, f1[3] * 8.f), pk4_fp8(f1[4] * 8.f, f1[5] * 8.f, f1[6] * 8.f, f1[7] * 8.f)};
      const long q8lo = __builtin_bit_cast(long, lo), q8hi = __builtin_bit_cast(long, hi);
      qb[0] = fr < 4 ? q8lo : 0l; qb[1] = fr < 4 ? q8hi : 0l; qb[2] = (fr >= 4 && fr < 8) ? q8lo : 0l; qb[3] = (fr >= 4 && fr < 8) ? q8hi : 0l;
    }
    u32x2 pk[16]; float ls = 0.f;
#pragma unroll
    for (int grp = 0; grp < 8; ++grp) {
      if (grp + 3 < 8) DSA_KISSUE((grp + 3) & 3, qq, grp + 3); else DSA_VISSUE((grp + 3) & 3, qq, grp + 3 - 8);
      __builtin_amdgcn_sched_barrier(0);
#pragma unroll
      for (int k2 = 0; k2 < 2; ++k2) {
        f32x4 a = {0.f, 0.f, 0.f, 0.f};
#pragma unroll
        for (int pr = 0; pr < 2; ++pr) {
          const u32x4 kw = ring[grp & 3][2 * k2 + pr];
          a = __builtin_amdgcn_mfma_f32_16x16x32_fp8_fp8(__builtin_bit_cast(long, (u32x2){kw.x, kw.y}), qb[2 * pr], a, 0, 0, 0);
          a = __builtin_amdgcn_mfma_f32_16x16x32_fp8_fp8(__builtin_bit_cast(long, (u32x2){kw.z, kw.w}), qb[2 * pr + 1], a, 0, 0, 0);
        }
        float pv[4];
#pragma unroll
        for (int r = 0; r < 4; ++r) { pv[r] = (32 * grp + 16 * k2 + 4 * fq + r < cnt) ? __builtin_amdgcn_exp2f(__builtin_fmaf(a[r], 0.125f, -shift)) : 0.f; ls += pv[r]; }
        pk[2 * grp + k2] = (u32x2){cvtpk(pv[0], pv[1]), cvtpk(pv[2], pv[3])};
      }
      __builtin_amdgcn_sched_barrier(0);
    }
    ls = rsum4(ls);
    const float linv = __builtin_amdgcn_rcpf(ls);
    f32x4 o[8];
#pragma unroll
    for (int dt = 0; dt < 8; ++dt) o[dt] = (f32x4){0.f, 0.f, 0.f, 0.f};
    const int vk8 = lane_o >> 3, vc = lane_o & 7;
    DSA_QISSUE(qnx);
#pragma unroll
    for (int s2 = 0; s2 < 8; ++s2) {
#pragma unroll
      for (int j = 0; j < 4; ++j) { const int key = 8 * j + vk8; char* d_ = vst + key * 256 + ((vc ^ (key & 7)) << 5); const u32x4 vv = ring[s2 & 3][j];
        const u32x2 a0 = fp8x4_bf16(vv.x), a1 = fp8x4_bf16(vv.y), a2 = fp8x4_bf16(vv.z), a3 = fp8x4_bf16(vv.w);
        *(u32x4*)d_ = (u32x4){a0.x, a0.y, a1.x, a1.y}; *(u32x4*)(d_ + 16) = (u32x4){a2.x, a2.y, a3.x, a3.y}; }
      __builtin_amdgcn_sched_barrier(0);
      if (s2 + 3 < 8) DSA_VISSUE((s2 + 3) & 3, qq, s2 + 3); else DSA_KISSUE((s2 + 3) & 3, qnx, s2 + 3 - 8);
      __builtin_amdgcn_sched_barrier(0);
      u32x4 w; w.x = pk[2 * s2].x; w.y = pk[2 * s2].y; w.z = pk[2 * s2 + 1].x; w.w = pk[2 * s2 + 1].y;
      const bf16x8 pb = __builtin_bit_cast(bf16x8, w);
      const int vkey = 4 * fq + (fr >> 2);
#pragma unroll
      for (int dt = 0; dt < 8; ++dt) {
        const char* vb = vst + vkey * 256 + ((dt ^ (vkey & 7)) << 5) + (lane_o & 3) * 8;
        const char* vb2 = vst + (vkey + 16) * 256 + ((dt ^ ((vkey + 16) & 7)) << 5) + (lane_o & 3) * 8;
        const v4i16_t lo4 = tr_read(vb), hi4 = tr_read(vb2);
        const bf16x8 a = (bf16x8){lo4[0], lo4[1], lo4[2], lo4[3], hi4[0], hi4[1], hi4[2], hi4[3]};
        o[dt] = MFMA16(a, pb, o[dt]);
      }
      __builtin_amdgcn_sched_barrier(0);
    }
    if (fr < 8) {
      f32x4 od[4];
#pragma unroll
      for (int dt = 0; dt < 4; ++dt) od[dt] = (fr < 4 ? o[dt] : o[dt + 4]) * linv;
      gated_store(outbuf + (tb + t) * 1024 + fr * 64, od, fq);
    }
  }
  __syncthreads();
}
#define GAS __attribute__((address_space(1)))
#define XB_TMO      128
#define XB_XCNT(j)  (256  + 64 * (j))
#define XB_XSUB(j)  (1280 + 64 * (j))
#define XB_XGEN(j)  (2304 + 64 * (j))
#define XB_TOP      3328
#define XB_TOPGEN   3392
#define XCD_BAR_WORDS 3456
#define XB_SPIN_CAP (1u << 18)

__device__ __forceinline__ unsigned xb_ld(unsigned* p)              { return __hip_atomic_load(p, __ATOMIC_RELAXED, __HIP_MEMORY_SCOPE_AGENT); }
__device__ __forceinline__ unsigned xb_add(unsigned* p, unsigned v) { return __hip_atomic_fetch_add(p, v, __ATOMIC_RELAXED, __HIP_MEMORY_SCOPE_AGENT); }
__device__ __forceinline__ unsigned xb_xcc_id() { return (unsigned)__builtin_amdgcn_s_getreg((3 << 11) | 20) & 0xFu; }
#define XB_SPIN(cond, bar) do { unsigned _sp = 0; while (cond) { __builtin_amdgcn_s_sleep(1); \
    if ((++_sp & 255u) == 0u) { if (xb_ld(&(bar)[XB_TMO])) break; if (_sp > XB_SPIN_CAP) { atomicAdd(&(bar)[XB_TMO], 1u); break; } } } } while (0)

struct XcdBarrier {
    unsigned* bar; unsigned x;
    volatile LAS unsigned* st;
};

__device__ __forceinline__ XcdBarrier xcd_barrier_post(unsigned* bar, volatile LAS unsigned* st) {
    XcdBarrier b; b.bar = bar; b.x = xb_xcc_id(); b.st = st;
    if (threadIdx.x == 0) (void)xb_add(&bar[XB_XCNT(b.x)], 1u);
    return b;
}
__device__ __forceinline__ void xcd_barrier_complete(unsigned* bar, unsigned x, unsigned& nloc, unsigned& nx) {
    const unsigned G = gridDim.x * gridDim.y * gridDim.z;
    unsigned sum, cnt, mine, sp = 0u;
    for (;;) {
        sum = 0u; cnt = 0u; mine = 0u;
#pragma unroll
        for (unsigned j = 0; j < 16; ++j) { const unsigned c = xb_ld(&bar[XB_XCNT(j)]); sum += c; cnt += (c > 0u) ? 1u : 0u; mine = (j == x) ? c : mine; }
        if (sum == G) break;
        __builtin_amdgcn_s_sleep(1);
        if ((++sp & 255u) == 0u) { if (xb_ld(&bar[XB_TMO])) break; if (sp > XB_SPIN_CAP) { atomicAdd(&bar[XB_TMO], 1u); break; } }
    }
    nloc = mine > 0u ? mine : 1u; nx = cnt > 0u ? cnt : 1u;
}

__device__ __forceinline__ void xcd_barrier(const XcdBarrier& b) {
    asm volatile("s_waitcnt vmcnt(0)" ::: "memory");
    __syncthreads();
    if (threadIdx.x == 0) {
        unsigned* bar = b.bar;
        __builtin_amdgcn_s_waitcnt(0);
        unsigned nloc = b.st[0], nx = b.st[1];
        if (nloc == 0u) { xcd_barrier_complete(bar, b.x, nloc, nx); b.st[0] = nloc; b.st[1] = nx; }
        const unsigned old = xb_add(&bar[XB_XSUB(b.x)], 1u);
        const unsigned gen = old / nloc;
        if (old + 1u == (gen + 1u) * nloc) {
            __builtin_amdgcn_fence(__ATOMIC_RELEASE, "agent");
            asm volatile("s_waitcnt vmcnt(0)" ::: "memory");
            const unsigned og = xb_add(&bar[XB_TOP], 1u);
            const unsigned tg = og / nx;
            if (og + 1u == (tg + 1u) * nx) xb_add(&bar[XB_TOPGEN], 1u);
            else XB_SPIN(xb_ld(&bar[XB_TOPGEN]) == tg, bar);
            __builtin_amdgcn_fence(__ATOMIC_ACQUIRE, "agent");
            xb_add(&bar[XB_XGEN(b.x)], 1u);
            asm volatile("s_waitcnt vmcnt(0)" ::: "memory");
        } else {
            XB_SPIN(xb_ld(&bar[XB_XGEN(b.x)]) == gen, bar);
            __builtin_amdgcn_fence(__ATOMIC_ACQUIRE, "agent");
            asm volatile("s_waitcnt vmcnt(0)" ::: "memory");
        }
    }
    __syncthreads();
}
constexpr int LDS_BYTES = 163840;
static_assert(LDS_BYTES >= DSA_LDS && LDS_BYTES >= pg8::STAGE_BYTES && LDS_BYTES >= NSA_LDS && LDS_BYTES >= 8 * 8704, "LDS budget");

constexpr size_t WS_CTR = WS_BAR + 14 * 1024;
__device__ __forceinline__ int grab_unit(unsigned* ctr, char* lds) {
  volatile int* slot = (volatile int*)(lds + LDS_BYTES - 32);
  if (threadIdx.x == 0) *slot = (int)__hip_atomic_fetch_add(ctr, 1u, __ATOMIC_RELAXED, __HIP_MEMORY_SCOPE_AGENT);
  __syncthreads();
  const int u = *slot;
  __syncthreads();
  return u;
}
#define RUN0 if (p.ph_hi > 0) { phase0(p, lds); }
#define RUN1 if (p.ph_hi > 1) { EpiProj<0> e{ws, p.in}; run_gemm(lds, (const u16*)(ws + WS_XB), (const u16*)(ws + WS_W0T), T, AB_N, DM, e, 46); }
#define RUN2 if (p.ph_hi > 2) { if (G == 256) { unsigned* ctr = (unsigned*)(ws + WS_CTR); \
                 for (;;) { const int u = grab_unit(ctr + (v >> 6) * 16, lds); if (u >= 128) break; dsa_unit<0>(lds, p, v >> 6, 127 - u, (u16*)(ws + WS_MIX)); } \
                 for (;;) { const int u = grab_unit(ctr + 128 + (v >> 5) * 16, lds); if (u >= 128) break; swa_unit(lds, p, v >> 6, (v >> 5) & 1, 127 - u); } } \
               else { for (int u = v; u < 256; u += G) { const int b = u >> 6, pi = u & 63; for (int i = 0; i < 2; ++i) dsa_unit<0>(lds, p, b, i == 0 ? pi : 127 - pi, (u16*)(ws + WS_MIX)); } \
                 for (int u = v; u < 1024; u += G) swa_unit(lds, p, u >> 8, (u >> 7) & 1, u & 127); } }
#define RUN2D if (p.ph_hi > 2) { for (int u = v; u < 256; u += G) { const int b = u >> 6, pi = u & 63; for (int i = 0; i < 2; ++i) dsa_unit<0>(lds, p, b, i == 0 ? pi : 127 - pi, (u16*)(ws + WS_MIX)); } }
#define RUN2S if (p.ph_hi > 2) { for (int u = v; u < 1024; u += G) swa_unit(lds, p, u >> 8, (u >> 7) & 1, u & 127); }
#define RUN6M if (p.ph_hi > 6) { MLA_LOOP(0, WS_MIX) }
#define RUN6N if (p.ph_hi > 6) { for (int u = v; u < 256; u += G) { const int b = u >> 6, kvh = (u >> 5) & 1, pi = u & 31; \
                 for (int i = 0; i < 4; ++i) { const int tl = (i == 0) ? 127 - pi : (i == 1) ? 64 + pi : (i == 2) ? 63 - pi : pi; nsa_unit<0>(lds, p, b, kvh, tl, (u16*)(ws + WS_MIX)); } } }
#ifndef XABL
#define XABL 0
#endif
#define RUNX if (p.ph_hi > 6) { MLA_LOOP(XABL, WS_XB) }
#define RUN2X if (p.ph_hi > 2) { for (int u = v; u < 256; u += G) { const int b = u >> 6, pi = u & 63; for (int i = 0; i < 2; ++i) dsa_unit<XABL>(lds, p, b, i == 0 ? 127 - pi : pi, (u16*)(ws + WS_XB)); } }
#define RUNG if (p.ph_hi > 1) { EpiNull e{(float*)(ws + WS_SSQ1P)}; run_gemm(lds, (const u16*)(ws + WS_XB), (const u16*)(ws + WS_W0T), T, AB_N, DM, e, 48); }
#define RUNXN if (p.ph_hi > 6) { for (int u = v; u < 256; u += G) { const int b = u >> 6, kvh = (u >> 5) & 1, pi = u & 31; \
                 for (int i = 0; i < 4; ++i) { const int tl = (i == 0) ? 127 - pi : (i == 1) ? 64 + pi : (i == 2) ? 63 - pi : pi; nsa_unit<XABL>(lds, p, b, kvh, tl, (u16*)(ws + WS_XB)); } } }
#define RUN3 if (p.ph_hi > 3) { EpiOut<0> e{ws, p.in[I_X], p.out}; run_gemm(lds, (const u16*)(ws + WS_MIX), (const u16*)(ws + WS_WO0T), T, DM, DM, e, 16); }
#define RUN4 if (p.ph_hi > 4) { EpiProj<1> e{ws, p.in}; run_gemm(lds, (const u16*)(ws + WS_XB), (const u16*)(ws + WS_W1T), T, CD_N, DM, e, 44); }
#define RUN5 if (p.ph_hi > 5) { for (int u = v; u < 256; u += G) cmp_unit(lds, p, u >> 7, u & 127); } \
             if (p.ph_hi > 5) { EpiUp<0> e{ws, p.in}; run_gemm(lds, (const u16*)(ws + L1_CQ), (const u16*)(ws + WS_WUQT), T, 768, 256, e, 12); } \
             if (p.ph_hi > 5) { EpiUp<1> e{ws, p.in}; run_gemm(lds, (const u16*)(ws + L1_CKV), (const u16*)(ws + WS_WUKVT), T, 1024, 128, e, 16); }
#define RUN5A if (p.ph_hi > 5) { for (int u = v; u < 256; u += G) cmp_unit(lds, p, u >> 7, u & 127); }
#define RUN5B if (p.ph_hi > 5) { EpiUp<0> e{ws, p.in}; run_gemm(lds, (const u16*)(ws + L1_CQ), (const u16*)(ws + WS_WUQT), T, 768, 256, e, 12); }
#define RUN5C if (p.ph_hi > 5) { EpiUp<1> e{ws, p.in}; run_gemm(lds, (const u16*)(ws + L1_CKV), (const u16*)(ws + WS_WUKVT), T, 1024, 128, e, 16); }
#define MLA_LOOP(ABL_, OUT_) for (int u = v; u < 256; u += G) { const int bh = u >> 3, i = u & 7; \
                 for (int r = 0; r < 2; ++r) { const int qb = (r == 0) ? 15 - i : i; \
                   mla_unit<ABL_>(lds, p, bh >> 3, bh & 7, qb, (u16*)(ws + OUT_)); } }
#define RUN6 if (p.ph_hi > 6) { if (G == 256) { unsigned* ctr = (unsigned*)(ws + WS_CTR); \
                 for (;;) { const int u = grab_unit(ctr + 256 + (v >> 5) * 16, lds); if (u >= 64) break; const int bh = 4 * (v >> 5) + (u & 3); mla_unit<0>(lds, p, bh >> 3, bh & 7, 15 - (u >> 2), (u16*)(ws + WS_MIX)); } \
                 for (;;) { const int u = grab_unit(ctr + 384 + (v >> 5) * 16, lds); if (u >= 128) break; nsa_unit<0>(lds, p, v >> 6, (v >> 5) & 1, 127 - u, (u16*)(ws + WS_MIX)); } } \
               else { MLA_LOOP(0, WS_MIX) \
                 for (int u = v; u < 256; u += G) { const int b = u >> 6, kvh = (u >> 5) & 1, pi = u & 31; \
                   for (int i = 0; i < 4; ++i) { const int tl = (i == 0) ? 127 - pi : (i == 1) ? 64 + pi : (i == 2) ? 63 - pi : pi; nsa_unit<0>(lds, p, b, kvh, tl, (u16*)(ws + WS_MIX)); } } } }
#define RUN7 if (p.ph_hi > 7) { EpiOut<1> e{ws, p.in[I_X], p.out}; run_gemm(lds, (const u16*)(ws + WS_MIX), (const u16*)(ws + WS_WO1T), T, DM, DM, e, 16); }
#define SYNC xcd_barrier(bar);
#define SYNC0 grid.sync();
#ifndef PROGRAM
#define PROGRAM RUN0 SYNC0 RUN1 SYNC RUN2 SYNC RUN3 SYNC RUN4 SYNC RUN5 SYNC RUN6 SYNC RUN7
#endif
__global__ void __launch_bounds__(512) mega_fwd(Params p) {
  extern __shared__ __attribute__((aligned(16))) char smem[];
  cg::grid_group grid = cg::this_grid();
  char* lds = smem;
  unsigned char* ws = p.ws;
  const int G = gridDim.x, v = vblock();
  volatile LAS unsigned* bst = (volatile LAS unsigned*)(LAS unsigned char*)(smem + LDS_BYTES - 16);
  if (threadIdx.x < 2) bst[threadIdx.x] = 0u;
  __syncthreads();
  XcdBarrier bar = xcd_barrier_post((unsigned*)(ws + WS_BAR), bst);
  PROGRAM
#if defined(DSA_CHECK) || defined(DSA_CHECK2)
  xcd_barrier(bar);
  { const float c = 1000.f * (1.f + (float)*(volatile unsigned*)(ws + WS_BAR + 15 * 1024));
    const float c2 = 10000.f * (1.f + (float)*(volatile unsigned*)(ws + WS_BAR + 15 * 1024 + 256));
    for (size_t i = (size_t)blockIdx.x * 512 + threadIdx.x; i < (size_t)T * DM; i += (size_t)G * 512) p.out[i] = (i == 0) ? c2 : c; }
#endif
}

#ifndef N_LAUNCHES
#define N_LAUNCHES 1
#endif
extern "C" void kernel_launch(void* const* d_in, const int* in_sizes, int n_in, void* d_out, int out_size, void* d_ws, size_t ws_size, hipStream_t stream) {
  static int grid_blocks = 0;
  if (grid_blocks == 0) {
    if (n_in != 22 || out_size != T * DM || ws_size < WS_NEED) { fprintf(stderr, "kernel_launch: unexpected problem (n_in %d, out %d, ws %zu < %zu)\n", n_in, out_size, ws_size, (size_t)WS_NEED); grid_blocks = -1; return; }
    int dev = 0, cus = 0, per_cu = 0;
    hipGetDevice(&dev);
    hipDeviceGetAttribute(&cus, hipDeviceAttributeMultiprocessorCount, dev);
    hipFuncSetAttribute((const void*)mega_fwd, hipFuncAttributeMaxDynamicSharedMemorySize, LDS_BYTES);
    hipOccupancyMaxActiveBlocksPerMultiprocessor(&per_cu, (const void*)mega_fwd, 512, LDS_BYTES);
    if (per_cu < 1) { fprintf(stderr, "kernel_launch: occupancy query says %d blocks per CU\n", per_cu); per_cu = 1; }
    grid_blocks = cus;
    if (grid_blocks > cus * per_cu) grid_blocks = cus * per_cu;
    grid_blocks &= ~7;
  }
  if (grid_blocks <= 0) return;
  if (hipMemsetAsync((char*)d_ws + WS_BAR, 0, 16384, stream) != hipSuccess) { fprintf(stderr, "kernel_launch: memset of the barrier words failed\n"); return; }
  Params p{};
  for (int i = 0; i < 22; ++i) p.in[i] = (const float*)d_in[i];
  p.out = (float*)d_out; p.ws = (unsigned char*)d_ws;
  for (int li = 0; li < N_LAUNCHES; ++li) {
    p.ph_lo = 0; p.ph_hi = 8;
    void* args[] = {&p};
    hipError_t e = hipLaunchCooperativeKernel((const void*)mega_fwd, dim3(grid_blocks), dim3(512), args, LDS_BYTES, stream);
    if (e != hipSuccess) fprintf(stderr, "cooperative launch failed: %s (grid %d)\n", hipGetErrorString(e), grid_blocks);
  }
}
```
